# Optimizing an MI355X kernel written in HIP

```python
import math
import jax, jax.numpy as jnp
from jax import lax
import numpy as np

D_MODEL = 1024
BATCH = 4
SEQ = 8192
DEPTH = 1

HEAD_DIM = 64
MOBA_HEADS = D_MODEL // (2 * HEAD_DIM)
DIFF_HEADS = D_MODEL // (4 * HEAD_DIM)
MOBA_WIDTH = MOBA_HEADS * HEAD_DIM
DIFF_QK_WIDTH = DIFF_HEADS * 2 * HEAD_DIM
DIFF_V_DIM = 2 * HEAD_DIM
DIFF_WIDTH = DIFF_HEADS * DIFF_V_DIM
MIX_WIDTH = MOBA_WIDTH + DIFF_WIDTH
IN_PROJ_WIDTH = 3 * MOBA_WIDTH + 2 * DIFF_QK_WIDTH + DIFF_WIDTH
MOBA_BLOCK = 256
MOBA_TOPK = 3
MOBA_QCHUNK = 32
DENSE_QBLOCK = 128
FFN_HIDDEN = ((8 * D_MODEL + 3 * 256 - 1) // (3 * 256)) * 256
ROPE_THETA = 10000.0
RMS_EPS = 1e-6

kernel_name = "hymba_moba_diffattn_swiglu"


def rms_norm(x, gain):
    xf = x.astype(jnp.float32)
    xf = xf * lax.rsqrt(jnp.mean(xf * xf, axis=-1, keepdims=True) + RMS_EPS)
    return (xf * gain.astype(jnp.float32)).astype(x.dtype)


def rope_tables(seq, dim):
    inv = 1.0 / (ROPE_THETA ** (jnp.arange(0, dim, 2, dtype=jnp.float32) / dim))
    ang = jnp.arange(seq, dtype=jnp.float32)[:, None] * inv[None, :]
    ang = jnp.concatenate([ang, ang], axis=-1)
    return jnp.cos(ang), jnp.sin(ang)


def apply_rope(x, cos, sin):
    half = x.shape[-1] // 2
    rot = jnp.concatenate([-x[..., half:], x[..., :half]], axis=-1)
    return (x.astype(jnp.float32) * cos + rot.astype(jnp.float32) * sin).astype(x.dtype)


def moba_attention(q, k, v):
    B, H, S, D = q.shape
    s_pad = -(-S // MOBA_BLOCK) * MOBA_BLOCK
    pad = ((0, 0), (0, 0), (0, s_pad - S), (0, 0))
    q, k, v = jnp.pad(q, pad), jnp.pad(k, pad), jnp.pad(v, pad)
    nb = s_pad // MOBA_BLOCK
    top_k = min(MOBA_TOPK, nb)
    scale = D ** -0.5
    kb = k.reshape(B, H, nb, MOBA_BLOCK, D)
    vb = v.reshape(B, H, nb, MOBA_BLOCK, D)
    k_mean = jnp.mean(kb.astype(jnp.float32), axis=3).astype(k.dtype)
    b_ix = jnp.arange(B)[:, None, None, None]
    h_ix = jnp.arange(H)[None, :, None, None]
    C = MOBA_QCHUNK

    def chunk(c):
        start = c * C
        blk = start // MOBA_BLOCK
        qc = lax.dynamic_slice_in_dim(q, start, C, axis=2)
        gate = jnp.einsum('bhqd,bhnd->bhqn', qc, k_mean).astype(jnp.float32)
        gate = jnp.where(jnp.arange(nb) < blk, gate, -jnp.inf)
        _, sel = lax.top_k(gate, top_k)
        sel_valid = jnp.arange(top_k) < blk
        k_sel = kb[b_ix, h_ix, sel]
        v_sel = vb[b_ix, h_ix, sel]
        s_sel = jnp.einsum('bhqd,bhqrkd->bhqrk', qc, k_sel).astype(jnp.float32) * scale
        s_sel = jnp.where(sel_valid[:, None], s_sel, -jnp.inf)
        s_sel = s_sel.reshape(B, H, C, top_k * MOBA_BLOCK)
        k_own = lax.dynamic_index_in_dim(kb, blk, axis=2, keepdims=False)
        v_own = lax.dynamic_index_in_dim(vb, blk, axis=2, keepdims=False)
        s_own = jnp.einsum('bhqd,bhkd->bhqk', qc, k_own).astype(jnp.float32) * scale
        q_pos = start + jnp.arange(C)
        k_pos = blk * MOBA_BLOCK + jnp.arange(MOBA_BLOCK)
        s_own = jnp.where(k_pos[None, :] <= q_pos[:, None], s_own, -jnp.inf)
        p = jax.nn.softmax(jnp.concatenate([s_sel, s_own], axis=-1), axis=-1)
        p_sel = p[..., :top_k * MOBA_BLOCK].reshape(B, H, C, top_k, MOBA_BLOCK).astype(v.dtype)
        p_own = p[..., top_k * MOBA_BLOCK:].astype(v.dtype)
        return (jnp.einsum('bhqrk,bhqrkd->bhqd', p_sel, v_sel)
                + jnp.einsum('bhqk,bhkd->bhqd', p_own, v_own))

    outs = lax.map(chunk, jnp.arange(s_pad // C))
    out = outs.transpose(1, 2, 0, 3, 4).reshape(B, H, s_pad, D)
    return out[:, :, :S]


def diff_attention(q, k, v, lam):
    B, H, _, S, D = q.shape
    scale = D ** -0.5
    QB = DENSE_QBLOCK
    k_pos = jnp.arange(S)

    def qblock(i):
        start = i * QB
        qb = lax.dynamic_slice_in_dim(q, start, QB, axis=3)
        s = jnp.einsum('bhmqd,bhmkd->bhmqk', qb, k).astype(jnp.float32) * scale
        mask = k_pos[None, :] <= (start + jnp.arange(QB))[:, None]
        p = jax.nn.softmax(jnp.where(mask, s, -jnp.inf), axis=-1)
        a = p[:, :, 0] - lam * p[:, :, 1]
        return jnp.einsum('bhqk,bhkd->bhqd', a.astype(v.dtype), v)

    outs = lax.map(qblock, jnp.arange(S // QB))
    return outs.transpose(1, 2, 0, 3, 4).reshape(B, H, S, v.shape[-1])


def setup_inputs(seed: int = 0) -> dict:
    key = jax.random.key(seed)
    ks = jax.random.split(key, 17)
    f32 = jnp.float32

    def nrm(k, shape, scale):
        return jax.random.normal(k, shape, f32) * scale

    def gain(k, shape):
        return 1.0 + 0.02 * jax.random.normal(k, shape, f32)

    L = DEPTH
    return {
        "x": jax.random.normal(ks[0], (BATCH, SEQ, D_MODEL), f32),
        "attn_norm": gain(ks[1], (L, D_MODEL)),
        "w_in": nrm(ks[2], (L, D_MODEL, IN_PROJ_WIDTH), D_MODEL ** -0.5),
        "moba_q_norm": gain(ks[3], (L, HEAD_DIM)),
        "moba_k_norm": gain(ks[4], (L, HEAD_DIM)),
        "diff_q_norm": gain(ks[5], (L, HEAD_DIM)),
        "diff_k_norm": gain(ks[6], (L, HEAD_DIM)),
        "lambda_q1": nrm(ks[7], (L, HEAD_DIM), 0.1),
        "lambda_k1": nrm(ks[8], (L, HEAD_DIM), 0.1),
        "lambda_q2": nrm(ks[9], (L, HEAD_DIM), 0.1),
        "lambda_k2": nrm(ks[10], (L, HEAD_DIM), 0.1),
        "diff_subln": gain(ks[11], (L, DIFF_V_DIM)),
        "w_out": nrm(ks[12], (L, MIX_WIDTH, D_MODEL), MIX_WIDTH ** -0.5),
        "ffn_norm": gain(ks[13], (L, D_MODEL)),
        "w_gate": nrm(ks[14], (L, D_MODEL, FFN_HIDDEN), D_MODEL ** -0.5),
        "w_up": nrm(ks[15], (L, D_MODEL, FFN_HIDDEN), D_MODEL ** -0.5),
        "w_down": nrm(ks[16], (L, FFN_HIDDEN, D_MODEL), FFN_HIDDEN ** -0.5),
    }


def reference(x, attn_norm, w_in, moba_q_norm, moba_k_norm, diff_q_norm, diff_k_norm,
              lambda_q1, lambda_k1, lambda_q2, lambda_k2, diff_subln, w_out,
              ffn_norm, w_gate, w_up, w_down):
    B, S, _ = x.shape
    cos, sin = rope_tables(S, HEAD_DIM)
    splits = [MOBA_WIDTH, 2 * MOBA_WIDTH, 3 * MOBA_WIDTH,
              3 * MOBA_WIDTH + DIFF_QK_WIDTH, 3 * MOBA_WIDTH + 2 * DIFF_QK_WIDTH]
    for l in range(DEPTH):
        lambda_init = 0.8 - 0.6 * math.exp(-0.3 * l)
        h = rms_norm(x, attn_norm[l])
        proj = jnp.einsum('bsd,de->bse', h, w_in[l])
        mq, mk, mv, dq, dk, dv = jnp.split(proj, splits, axis=-1)

        mq = rms_norm(mq.reshape(B, S, MOBA_HEADS, HEAD_DIM), moba_q_norm[l]).transpose(0, 2, 1, 3)
        mk = rms_norm(mk.reshape(B, S, MOBA_HEADS, HEAD_DIM), moba_k_norm[l]).transpose(0, 2, 1, 3)
        mv = mv.reshape(B, S, MOBA_HEADS, HEAD_DIM).transpose(0, 2, 1, 3)
        mq, mk = apply_rope(mq, cos, sin), apply_rope(mk, cos, sin)
        moba_out = moba_attention(mq, mk, mv)
        moba_out = moba_out.transpose(0, 2, 1, 3).reshape(B, S, MOBA_WIDTH)

        dq = rms_norm(dq.reshape(B, S, DIFF_HEADS, 2, HEAD_DIM), diff_q_norm[l]).transpose(0, 2, 3, 1, 4)
        dk = rms_norm(dk.reshape(B, S, DIFF_HEADS, 2, HEAD_DIM), diff_k_norm[l]).transpose(0, 2, 3, 1, 4)
        dv = dv.reshape(B, S, DIFF_HEADS, DIFF_V_DIM).transpose(0, 2, 1, 3)
        dq, dk = apply_rope(dq, cos, sin), apply_rope(dk, cos, sin)
        lam = (jnp.exp(jnp.sum(lambda_q1[l].astype(jnp.float32) * lambda_k1[l].astype(jnp.float32)))
               - jnp.exp(jnp.sum(lambda_q2[l].astype(jnp.float32) * lambda_k2[l].astype(jnp.float32)))
               + lambda_init)
        diff_out = diff_attention(dq, dk, dv, lam)
        diff_out = rms_norm(diff_out, diff_subln[l]) * (1.0 - lambda_init)
        diff_out = diff_out.transpose(0, 2, 1, 3).reshape(B, S, DIFF_WIDTH)

        mixed = jnp.concatenate([moba_out, diff_out], axis=-1)
        x = x + jnp.einsum('bse,ed->bsd', mixed, w_out[l])

        h = rms_norm(x, ffn_norm[l])
        g = jnp.einsum('bsd,df->bsf', h, w_gate[l])
        u = jnp.einsum('bsd,df->bsf', h, w_up[l])
        x = x + jnp.einsum('bsf,fd->bsd', jax.nn.silu(g) * u, w_down[l])
    return x
```

```cpp
#include <hip/hip_runtime.h>
#include <cstdio>
#include <cstdint>
namespace pg8 {
#define PG8_LAS __attribute__((address_space(3)))
typedef unsigned short bf16_t;
typedef short bf16x8 __attribute__((ext_vector_type(8)));
typedef float f32x4 __attribute__((ext_vector_type(4)));
typedef unsigned u32x4 __attribute__((ext_vector_type(4)));
constexpr int BM = 256, BK = 64, HALF = 128, HTB = HALF * BK * 2  , STAGE_BYTES = 8 * HTB, NXCD = 8, WGM = 8;

__host__ __device__ __forceinline__ int lds_byte(int r, int c) { const int st = (r >> 4) * 2 + (c >> 5), rr = r & 15, cc = c & 31, ob = rr * 64 + cc * 2; return st * 1024 + (ob ^ (((ob >> 9) & 1) << 5)); }
__host__ __device__ __forceinline__ void stage_rc(int b, int& R, int& C) { const int st = b / 1024, sb = b % 1024, swz = sb ^ (((sb >> 9) & 1) << 5); R = (st >> 1) * 16 + swz / 64; C = (st & 1) * 32 + (swz % 64) / 2; }
__host__ __device__ __forceinline__ int perm32(int rho) { const int n = rho >> 4, i = rho & 15; return 8 * (i >> 2) + 4 * n + (i & 3); }

struct Unit { int pm, pn; };
struct Gemm { const bf16_t* A; const bf16_t* Bt; int M, N, K; };

struct StaticOrder {
    int nM, nN, nwg, G, c;
    __host__ __device__ void init(int M, int N, int G_, int c_) { nM = M / BM; nN = N / BM; nwg = nM * nN; G = G_; c = c_; }
    __host__ __device__ bool next(int i, Unit& u) const {
        const long L = (long)i * G + c; if (L >= nwg) return false;
        int wgid = (int)L; { const int q = nwg / NXCD, r = nwg % NXCD, xcd = wgid % NXCD, off = wgid / NXCD; wgid = (xcd < r ? xcd * (q + 1) : r * (q + 1) + (xcd - r) * q) + off; }
        const int nig = WGM * nN, gid = wgid / nig, fm = gid * WGM, gsz = (nM - fm) < WGM ? (nM - fm) : WGM;
        u.pm = fm + ((wgid % nig) % gsz); u.pn = (wgid % nig) / gsz; return true;
    }
    __device__ __forceinline__ void a_ready(const Unit&) const {}
    __device__ __forceinline__ void done(const Unit&) const {}
};

__device__ __forceinline__ unsigned cvt_pk_bf16(float lo, float hi) { unsigned r; asm volatile("v_cvt_pk_bf16_f32 %0, %1, %2" : "=v"(r) : "v"(lo), "v"(hi)); return r; }
typedef float f32x2 __attribute__((ext_vector_type(2)));
typedef unsigned u32x2 __attribute__((ext_vector_type(2)));
__device__ __forceinline__ float xsum_fq(float s) { s += __shfl_xor(s, 16); s += __shfl_xor(s, 32); return s; }

struct EpiQKV {
    static constexpr bool PERM = true, AFTER_DRAIN = false;
    bf16_t* O; const float* gtab; const float* rcos; const float* rsin; float qscale; float* kpart;
    __device__ __forceinline__ void operator()(const f32x4 (&acc)[2][2][4][2], const Unit& u, int wr, int wc, int fr_, int fq_) const {
        int fr = fr_, fq = fq_; asm volatile("" : "+v"(fr), "+v"(fq));
        const int t = u.pn >> 1;
        const int hh = u.pn * 4 + wc;
        const int row0 = u.pm * BM + wr * 64 + fr;
        if (t == 2 || t == 5) {
#pragma unroll
            for (int ai = 0; ai < 2; ++ai)
#pragma unroll
                for (int m = 0; m < 4; ++m) { const int row = row0 + ai * HALF + m * 16; bf16_t* rowp = O + ((size_t)((row >> 13) * 48 + hh) * 8192 + (row & 8191)) * 64 + 8 * fq;
#pragma unroll
                    for (int bj = 0; bj < 2; ++bj) { const f32x4 v0 = acc[ai][bj][m][0], v1 = acc[ai][bj][m][1]; u32x4 w;
                        w.x = cvt_pk_bf16(v0[0], v0[1]); w.y = cvt_pk_bf16(v0[2], v0[3]); w.z = cvt_pk_bf16(v1[0], v1[1]); w.w = cvt_pk_bf16(v1[2], v1[3]);
                        *(u32x4*)(rowp + bj * 32) = w; } }
        } else {
            const float* g = gtab + t * 64;
            const float sc = (t == 0 || t == 3) ? qscale : 1.0f;
            f32x4 gv[2][2];
#pragma unroll
            for (int bj = 0; bj < 2; ++bj)
#pragma unroll
                for (int n = 0; n < 2; ++n) gv[bj][n] = *(const f32x4*)(g + 32 * bj + 8 * fq + 4 * n) * sc;
#pragma unroll
            for (int ai = 0; ai < 2; ++ai)
#pragma unroll
                for (int m = 0; m < 4; ++m) {
                    const int row = row0 + ai * HALF + m * 16; const int pos = row & 8191;
                    float ss = 0.f;
#pragma unroll
                    for (int bj = 0; bj < 2; ++bj)
#pragma unroll
                        for (int n = 0; n < 2; ++n) { const f32x4 x = acc[ai][bj][m][n]; ss += (x[0] * x[0] + x[1] * x[1]) + (x[2] * x[2] + x[3] * x[3]); }
                    ss = xsum_fq(ss);
                    const float rstd = __builtin_amdgcn_rsqf(ss * (1.0f / 64.0f) + 1e-6f);
                    u32x4 wlo, whi;
#pragma unroll
                    for (int n = 0; n < 2; ++n) {
                        const f32x4 c = *(const f32x4*)(rcos + pos * 32 + 8 * fq + 4 * n), s = *(const f32x4*)(rsin + pos * 32 + 8 * fq + 4 * n);
                        const f32x4 lo = acc[ai][0][m][n] * rstd * gv[0][n], hi = acc[ai][1][m][n] * rstd * gv[1][n];
                        const f32x4 olo = lo * c - hi * s, ohi = hi * c + lo * s;
                        if (n == 0) { wlo.x = cvt_pk_bf16(olo[0], olo[1]); wlo.y = cvt_pk_bf16(olo[2], olo[3]); whi.x = cvt_pk_bf16(ohi[0], ohi[1]); whi.y = cvt_pk_bf16(ohi[2], ohi[3]); }
                        else        { wlo.z = cvt_pk_bf16(olo[0], olo[1]); wlo.w = cvt_pk_bf16(olo[2], olo[3]); whi.z = cvt_pk_bf16(ohi[0], ohi[1]); whi.w = cvt_pk_bf16(ohi[2], ohi[3]); }
                    }
                    bf16_t* rowp = O + ((size_t)((row >> 13) * 48 + hh) * 8192 + pos) * 64 + 8 * fq;
                    *(u32x4*)(rowp) = wlo; *(u32x4*)(rowp + 32) = whi;
                }
            if (t == 1) {
                asm volatile("" ::: "memory");
                f32x4 cs[2][2];
#pragma unroll
                for (int bj = 0; bj < 2; ++bj)
#pragma unroll
                    for (int n = 0; n < 2; ++n) cs[bj][n] = (f32x4){0.f, 0.f, 0.f, 0.f};
#pragma unroll
                for (int ai = 0; ai < 2; ++ai)
#pragma unroll
                    for (int m = 0; m < 4; ++m) {
                        const int row = row0 + ai * HALF + m * 16; const int pos = row & 8191;
                        float ss = 0.f;
#pragma unroll
                        for (int bj = 0; bj < 2; ++bj)
#pragma unroll
                            for (int n = 0; n < 2; ++n) { const f32x4 x = acc[ai][bj][m][n]; ss += (x[0] * x[0] + x[1] * x[1]) + (x[2] * x[2] + x[3] * x[3]); }
                        ss = xsum_fq(ss);
                        const float rstd = __builtin_amdgcn_rsqf(ss * (1.0f / 64.0f) + 1e-6f);
#pragma unroll
                        for (int n = 0; n < 2; ++n) {
                            const f32x4 c = *(const f32x4*)(rcos + pos * 32 + 8 * fq + 4 * n), sn = *(const f32x4*)(rsin + pos * 32 + 8 * fq + 4 * n);
                            const f32x4 lo = acc[ai][0][m][n] * rstd * gv[0][n], hi = acc[ai][1][m][n] * rstd * gv[1][n];
                            cs[0][n] += lo * c - hi * sn; cs[1][n] += hi * c + lo * sn;
                        }
                        asm volatile("" ::: "memory");
                    }
#pragma unroll
                for (int bj = 0; bj < 2; ++bj)
#pragma unroll
                    for (int n = 0; n < 2; ++n)
#pragma unroll
                        for (int j = 0; j < 4; ++j) { float v = cs[bj][n][j]; v += __shfl_xor(v, 1); v += __shfl_xor(v, 2); v += __shfl_xor(v, 4); v += __shfl_xor(v, 8); cs[bj][n][j] = v; }
                if (fr == 0) { float* kp = kpart + ((size_t)(((u.pm >> 5) * 8 + (hh - 8)) * 32 + (u.pm & 31)) * 2 + wr) * 64 + 8 * fq;
                    *(f32x4*)(kp) = cs[0][0]; *(f32x4*)(kp + 4) = cs[0][1]; *(f32x4*)(kp + 32) = cs[1][0]; *(f32x4*)(kp + 36) = cs[1][1]; }
            }
        }
    }
};
struct EpiOut {
    static constexpr bool PERM = true, AFTER_DRAIN = false;
    const float* X; bf16_t* XB; float* SS;
    __device__ __forceinline__ void operator()(const f32x4 (&acc)[2][2][4][2], const Unit& u, int wr, int wc, int fr, int fq) const {
        const int col0 = u.pn * 256 + wc * 32 + 8 * fq;
        const int row0 = u.pm * BM + wr * 64 + fr;
#pragma unroll
        for (int ai = 0; ai < 2; ++ai)
#pragma unroll
            for (int m = 0; m < 4; ++m) { const int row = row0 + ai * HALF + m * 16; const size_t off = (size_t)row * 1024 + col0; float ss = 0.f;
#pragma unroll
                for (int bj = 0; bj < 2; ++bj) {
                    const f32x4 v0 = __builtin_nontemporal_load((const f32x4*)(X + off + bj * HALF)) + acc[ai][bj][m][0], v1 = __builtin_nontemporal_load((const f32x4*)(X + off + bj * HALF + 4)) + acc[ai][bj][m][1];
                    ss += (v0[0] * v0[0] + v0[1] * v0[1]) + (v0[2] * v0[2] + v0[3] * v0[3]) + (v1[0] * v1[0] + v1[1] * v1[1]) + (v1[2] * v1[2] + v1[3] * v1[3]);
                    u32x4 w; w.x = cvt_pk_bf16(v0[0], v0[1]); w.y = cvt_pk_bf16(v0[2], v0[3]); w.z = cvt_pk_bf16(v1[0], v1[1]); w.w = cvt_pk_bf16(v1[2], v1[3]);
                    *(u32x4*)(XB + off + bj * HALF) = w; }
                ss = xsum_fq(ss);
                if (fq == 0) SS[(size_t)row * 16 + u.pn * 4 + wc] = ss; }
    }
};
struct EpiSwiGLU {
    static constexpr bool PERM = true, AFTER_DRAIN = false;
    const float* SS; bf16_t* H;
    __device__ __forceinline__ void operator()(const f32x4 (&acc)[2][2][4][2], const Unit& u, int wr, int wc, int fr, int fq) const {
        const int col0 = u.pn * 128 + wc * 32 + 8 * fq;
        const int row0 = u.pm * BM + wr * 64 + fr;
#pragma unroll
        for (int ai = 0; ai < 2; ++ai)
#pragma unroll
            for (int m = 0; m < 4; ++m) { const int row = row0 + ai * HALF + m * 16;
                const f32x4* sp = (const f32x4*)(SS + (size_t)row * 16); const f32x4 a = sp[0], b = sp[1], c = sp[2], d = sp[3];
                const float tot = ((a[0] + a[1]) + (a[2] + a[3])) + ((b[0] + b[1]) + (b[2] + b[3])) + ((c[0] + c[1]) + (c[2] + c[3])) + ((d[0] + d[1]) + (d[2] + d[3]));
                const float rstd = __builtin_amdgcn_rsqf(tot * (1.0f / 1024.0f) + 1e-6f);
                unsigned w[4];
#pragma unroll
                for (int n = 0; n < 2; ++n) { const f32x4 g = acc[ai][0][m][n] * rstd, uu = acc[ai][1][m][n] * rstd; float h[4];
#pragma unroll
                    for (int j = 0; j < 4; ++j) h[j] = g[j] * uu[j] * __builtin_amdgcn_rcpf(1.0f + __builtin_amdgcn_exp2f(-1.4426950408889634f * g[j]));
                    w[2 * n] = cvt_pk_bf16(h[0], h[1]); w[2 * n + 1] = cvt_pk_bf16(h[2], h[3]); }
                *(u32x4*)(H + (size_t)row * 2816 + col0) = (u32x4){w[0], w[1], w[2], w[3]}; }
    }
};
struct EpiDown {
    static constexpr bool PERM = true, AFTER_DRAIN = false;
    const bf16_t* XB; float* Y;
    __device__ __forceinline__ void operator()(const f32x4 (&acc)[2][2][4][2], const Unit& u, int wr, int wc, int fr, int fq) const {
        const int col0 = u.pn * 256 + wc * 32 + 8 * fq;
        const int row0 = u.pm * BM + wr * 64 + fr;
#pragma unroll
        for (int ai = 0; ai < 2; ++ai)
#pragma unroll
            for (int m = 0; m < 4; ++m) { const size_t off = (size_t)(row0 + ai * HALF + m * 16) * 1024 + col0;
#pragma unroll
                for (int bj = 0; bj < 2; ++bj) {
                    const u32x4 xb = __builtin_nontemporal_load((const u32x4*)(XB + off + bj * HALF));
                    const f32x4 x0 = {__builtin_bit_cast(float, xb.x << 16), __builtin_bit_cast(float, xb.x & 0xffff0000u), __builtin_bit_cast(float, xb.y << 16), __builtin_bit_cast(float, xb.y & 0xffff0000u)};
                    const f32x4 x1 = {__builtin_bit_cast(float, xb.z << 16), __builtin_bit_cast(float, xb.z & 0xffff0000u), __builtin_bit_cast(float, xb.w << 16), __builtin_bit_cast(float, xb.w & 0xffff0000u)};
                    const f32x4 v0 = x0 + acc[ai][bj][m][0], v1 = x1 + acc[ai][bj][m][1];
                    __builtin_nontemporal_store(v0, (f32x4*)(Y + off + bj * HALF)); __builtin_nontemporal_store(v1, (f32x4*)(Y + off + bj * HALF + 4)); } }
    }
};

template <class Epi, class Sched, bool ALIGN_EPI = false, bool SP2 = false>
__device__ __forceinline__ void gemm_phase(PG8_LAS unsigned char* lds, const Gemm g, const Sched& S, const Epi& E) {
    int tid_ = threadIdx.x; asm volatile("" : "+v"(tid_));
    const int tid = tid_, wid = __builtin_amdgcn_readfirstlane(tid >> 6), lane = tid & 63, wr = wid >> 2, wc = wid & 3, fr = lane & 15, fq = lane >> 4;
    const int K = g.K, nt = K / BK;
    unsigned voffA[2], voffB[2];
#pragma unroll
    for (int i = 0; i < 2; ++i) { int R, C; stage_rc(tid * 16 + i * 8192, R, C); const int Rb = Epi::PERM ? ((R & ~31) + perm32(R & 31)) : R;
        voffA[i] = (unsigned)(R * K + C) * 2u; voffB[i] = (unsigned)(Rb * K + C) * 2u; }
    const size_t kstep = (size_t)(BK * 2);
    const size_t hstep = (size_t)HALF * K * 2;
    const size_t tstep = 2 * hstep;
    const unsigned ldsw = (unsigned)wid * 1024u;
    const int aoff = lds_byte(wr * 64 + fr, fq * 8), boff = lds_byte(wc * 32 + fr, fq * 8);
#define PG8_SA(b, h) (((b) * 2 + (h)) * HTB)
#define PG8_SB(b, h) ((4 + (b) * 2 + (h)) * HTB)
#define PG8_STAGE(bufoff, gbase, voff) do { _Pragma("unroll") for (int _i = 0; _i < 2; ++_i) \
        __builtin_amdgcn_global_load_lds((const unsigned*)((const char*)(gbase) + (voff)[_i]), (PG8_LAS unsigned*)(lds + (bufoff) + ldsw + _i * 8192), 16, 0, 0); } while (0)
#define PG8_LDA(dst, b, h) do { _Pragma("unroll") for (int m = 0; m < 4; ++m) _Pragma("unroll") for (int k = 0; k < 2; ++k) dst[m][k] = *(const PG8_LAS bf16x8*)(lds + PG8_SA(b, h) + aoff + m * 2048 + k * 1024); } while (0)
#define PG8_LDB(dst, b, h) do { _Pragma("unroll") for (int n = 0; n < 2; ++n) _Pragma("unroll") for (int k = 0; k < 2; ++k) dst[n][k] = *(const PG8_LAS bf16x8*)(lds + PG8_SB(b, h) + boff + n * 2048 + k * 1024); } while (0)
#define PG8_MMA(ai, bj, At, Bt) do { __builtin_amdgcn_s_setprio(1); _Pragma("unroll") for (int m = 0; m < 4; ++m) _Pragma("unroll") for (int n = 0; n < 2; ++n) _Pragma("unroll") for (int k = 0; k < 2; ++k) \
        acc[ai][bj][m][n] = __builtin_amdgcn_mfma_f32_16x16x32_bf16(Bt[n][k], At[m][k], acc[ai][bj][m][n], 0, 0, 0); __builtin_amdgcn_s_setprio(0); } while (0)
#define PG8_WAIT_V(n) asm volatile("s_waitcnt vmcnt(" #n ")" ::: "memory")
#define PG8_WAIT_L(n) asm volatile("s_waitcnt lgkmcnt(" #n ")" ::: "memory")
#define PG8_BAR __builtin_amdgcn_s_barrier()
#define PG8_SCHED __builtin_amdgcn_sched_barrier(0)
    Unit cur, nxt; int ui = 0;
    if (!S.next(0, cur)) return;
    f32x4 acc[2][2][4][2];
#pragma unroll
    for (int a = 0; a < 2; ++a)
#pragma unroll
        for (int b = 0; b < 2; ++b)
#pragma unroll
            for (int m = 0; m < 4; ++m)
#pragma unroll
                for (int n = 0; n < 2; ++n) acc[a][b][m][n] = (f32x4){0.f, 0.f, 0.f, 0.f};
    bf16x8 At[4][2], B0[2][2], B1[2][2];
    const char* cA = (const char*)g.A + (size_t)cur.pm * tstep; const char* cB = (const char*)g.Bt + (size_t)cur.pn * tstep;
    S.a_ready(cur);
    if constexpr (SP2) {
        PG8_STAGE(PG8_SB(0, 0), cB, voffB); PG8_STAGE(PG8_SB(0, 1), cB + hstep, voffB); PG8_STAGE(PG8_SA(0, 0), cA, voffA); PG8_STAGE(PG8_SA(0, 1), cA + hstep, voffA);
        if (wr == 1) PG8_BAR;
        PG8_WAIT_V(2); PG8_BAR;
        PG8_STAGE(PG8_SB(1, 0), cB + kstep, voffB); PG8_STAGE(PG8_SA(1, 0), cA + kstep, voffA); PG8_STAGE(PG8_SB(1, 1), cB + hstep + kstep, voffB);
        PG8_WAIT_V(6); PG8_BAR;
    } else {
        PG8_STAGE(PG8_SB(0, 0), cB, voffB); PG8_STAGE(PG8_SA(0, 0), cA, voffA); PG8_STAGE(PG8_SB(0, 1), cB + hstep, voffB); PG8_STAGE(PG8_SA(0, 1), cA + hstep, voffA);
        if (wr == 1) PG8_BAR;
        PG8_WAIT_V(4); PG8_BAR;
        PG8_STAGE(PG8_SB(1, 0), cB + kstep, voffB); PG8_STAGE(PG8_SA(1, 0), cA + kstep, voffA); PG8_STAGE(PG8_SB(1, 1), cB + hstep + kstep, voffB);
        PG8_WAIT_V(6); PG8_BAR;
    }
    for (;;) {
        const bool has_next = S.next(ui + 1, nxt);
        const char* nA = has_next ? (const char*)g.A + (size_t)nxt.pm * tstep : cA; const char* nB = has_next ? (const char*)g.Bt + (size_t)nxt.pn * tstep : cB;
        for (int t = 0; t < nt; t += 2) {
            const bool last = (t == nt - 2);
            const char* a1 = cA + (size_t)(t + 1) * kstep;
            const char* a2 = last ? nA : cA + (size_t)(t + 2) * kstep; const char* b2 = last ? nB : cB + (size_t)(t + 2) * kstep;
            const char* a3 = a2 + kstep; const char* b3 = b2 + kstep;
            if (last && has_next) S.a_ready(nxt);
            if constexpr (SP2) {
            PG8_LDB(B0, 0, 0); PG8_LDB(B1, 0, 1); PG8_SCHED; PG8_LDA(At, 0, 0); PG8_STAGE(PG8_SA(1, 1), a1 + hstep, voffA);
            PG8_WAIT_V(8); PG8_WAIT_L(0); PG8_BAR; PG8_MMA(0, 0, At, B0); PG8_MMA(0, 1, At, B1); PG8_BAR; PG8_SCHED;
            PG8_LDA(At, 0, 1); PG8_STAGE(PG8_SB(0, 0), b2, voffB); PG8_STAGE(PG8_SB(0, 1), b2 + hstep, voffB); PG8_STAGE(PG8_SA(0, 0), a2, voffA);
            PG8_WAIT_V(8); PG8_WAIT_L(0); PG8_BAR; PG8_MMA(1, 0, At, B0); PG8_MMA(1, 1, At, B1); PG8_BAR; PG8_SCHED;
            PG8_LDB(B0, 1, 0); PG8_LDB(B1, 1, 1); PG8_SCHED; PG8_LDA(At, 1, 0); PG8_STAGE(PG8_SA(0, 1), a2 + hstep, voffA);
            PG8_WAIT_V(8); PG8_WAIT_L(0); PG8_BAR; PG8_MMA(0, 0, At, B0); PG8_MMA(0, 1, At, B1); PG8_BAR; PG8_SCHED;
            PG8_LDA(At, 1, 1); PG8_STAGE(PG8_SB(1, 0), b3, voffB); PG8_STAGE(PG8_SB(1, 1), b3 + hstep, voffB); PG8_STAGE(PG8_SA(1, 0), a3, voffA);
            PG8_WAIT_V(8); PG8_WAIT_L(0); PG8_BAR; PG8_MMA(1, 0, At, B0); PG8_MMA(1, 1, At, B1); PG8_BAR; PG8_SCHED;
            } else {
            PG8_LDB(B0, 0, 0); PG8_SCHED; PG8_LDA(At, 0, 0); PG8_STAGE(PG8_SA(1, 1), a1 + hstep, voffA);
            PG8_WAIT_L(8); PG8_BAR; PG8_WAIT_L(0); PG8_MMA(0, 0, At, B0); PG8_BAR; PG8_SCHED;
            PG8_LDB(B1, 0, 1); PG8_STAGE(PG8_SB(0, 0), b2, voffB);
            PG8_BAR; PG8_WAIT_L(0); PG8_MMA(0, 1, At, B1); PG8_BAR;
            PG8_LDA(At, 0, 1); PG8_STAGE(PG8_SA(0, 0), a2, voffA);
            PG8_BAR; PG8_WAIT_L(0); PG8_MMA(1, 0, At, B0); PG8_BAR; PG8_SCHED;
            PG8_STAGE(PG8_SB(0, 1), b2 + hstep, voffB);
            PG8_WAIT_V(6); PG8_BAR; PG8_MMA(1, 1, At, B1); PG8_BAR;
            PG8_LDB(B0, 1, 0); PG8_SCHED; PG8_LDA(At, 1, 0); PG8_STAGE(PG8_SA(0, 1), a2 + hstep, voffA);
            PG8_WAIT_L(8); PG8_BAR; PG8_WAIT_L(0); PG8_MMA(0, 0, At, B0); PG8_BAR; PG8_SCHED;
            PG8_LDB(B1, 1, 1); PG8_STAGE(PG8_SB(1, 0), b3, voffB);
            PG8_BAR; PG8_WAIT_L(0); PG8_MMA(0, 1, At, B1); PG8_BAR;
            PG8_LDA(At, 1, 1); PG8_STAGE(PG8_SA(1, 0), a3, voffA);
            PG8_BAR; PG8_WAIT_L(0); PG8_MMA(1, 0, At, B0); PG8_BAR; PG8_SCHED;
            PG8_STAGE(PG8_SB(1, 1), b3 + hstep, voffB);
            PG8_WAIT_V(6); PG8_BAR; PG8_MMA(1, 1, At, B1); PG8_BAR;
            }
        }
        if constexpr (ALIGN_EPI) { if (wr == 0) PG8_BAR; }
        if constexpr (!Epi::AFTER_DRAIN) { E(acc, cur, wr, wc, fr, fq); S.done(cur); }
        if (!has_next) break;
#pragma unroll
        for (int a = 0; a < 2; ++a)
#pragma unroll
            for (int b = 0; b < 2; ++b)
#pragma unroll
                for (int m = 0; m < 4; ++m)
#pragma unroll
                    for (int n = 0; n < 2; ++n) acc[a][b][m][n] = (f32x4){0.f, 0.f, 0.f, 0.f};
        cur = nxt; cA = nA; cB = nB; ++ui;
        if constexpr (ALIGN_EPI) { if (wr == 1) PG8_BAR; }
    }
    PG8_WAIT_V(0);
    if constexpr (!ALIGN_EPI) { if (wr == 0) PG8_BAR; }
    PG8_BAR;
    if constexpr (Epi::AFTER_DRAIN) { E.fused(acc, cur, wr, wc, fr, fq, lds, wid, lane); S.done(cur); }
#undef PG8_SA
#undef PG8_SB
#undef PG8_STAGE
#undef PG8_LDA
#undef PG8_LDB
#undef PG8_MMA
#undef PG8_WAIT_V
#undef PG8_WAIT_L
#undef PG8_BAR
#undef PG8_SCHED
}
}

#ifndef PG8_SP2
#define PG8_SP2 true
#endif
#ifndef PG8_ALIGN
#define PG8_ALIGN true
#endif
#include <hip/hip_bf16.h>
#include <cmath>
namespace attn_body {
using bf16=__hip_bfloat16;
using bf16x8=__attribute__((ext_vector_type(8)))short;
using s16x4=__attribute__((ext_vector_type(4)))short;
using f32x16=__attribute__((ext_vector_type(16)))float;
using u32x4=__attribute__((ext_vector_type(4)))unsigned;
constexpr int SEQ=8192,D=64,PQ=64,PO=1024;
constexpr int NW=8,QBLK=32,QB=QBLK*NW,KVBLK=64,NQB=SEQ/QB;
constexpr int ATTN_UNIT_ROWS=QB;
__device__ __forceinline__ int crow(int r,int hi){return (r&3)+8*(r>>2)+4*hi;}
#define SBAR() __builtin_amdgcn_sched_barrier(0)
__device__ __forceinline__ void cmask(f32x16&p0,f32x16&p1,int jb,int qrel,int hi){
  const float NEG=-INFINITY; int kb=64*jb+4*hi;
  #pragma unroll
  for(int r=0;r<16;++r){int kv=kb+(r&3)+8*(r>>2); if(kv>qrel)p0[r]=NEG; if(kv+32>qrel)p1[r]=NEG;}
}

constexpr int NSLOT=3, SLOTB=8192;
constexpr int LDS_K=0, LDS_V=NSLOT*SLOTB, LDS_WS=2*NSLOT*SLOTB, LDS_OST=LDS_WS+NW*64*4, LDS_BYTES=LDS_OST+NW*4096;
constexpr float C2=0.125f*1.4426950408889634f;
__device__ __forceinline__ void glds16(const void*gsrc,unsigned lds_dst){unsigned keep;
  asm volatile("s_mov_b32 %0, m0\n\ts_mov_b32 m0, %2\n\ts_nop 0\n\tglobal_load_lds_dwordx4 %1, off\n\ts_mov_b32 m0, %0":"=&s"(keep):"v"(gsrc),"s"(lds_dst):"memory");}
__device__ __forceinline__ float max3f(float a,float b,float c){float r;asm("v_max3_f32 %0, %1, %2, %3":"=v"(r):"v"(a),"v"(b),"v"(c));return r;}
__device__ __forceinline__ float max2f(float a,float b){float r;asm("v_max_f32_e32 %0, %1, %2":"=v"(r):"v"(a),"v"(b));return r;}
__device__ __forceinline__ float fadd_s(float a,float b){float r;asm("v_add_f32_e32 %0, %1, %2":"=v"(r):"v"(a),"v"(b));return r;}
__device__ __forceinline__ float fsub_s(float a,float b){float r;asm("v_sub_f32_e32 %0, %1, %2":"=v"(r):"v"(a),"v"(b));return r;}
typedef float f32x2_t __attribute__((ext_vector_type(2))); typedef __bf16 bf16x2_t __attribute__((ext_vector_type(2)));
__device__ __forceinline__ unsigned cvtpk_s(float lo,float hi){f32x2_t v={lo,hi};bf16x2_t b=__builtin_convertvector(v,bf16x2_t);return __builtin_bit_cast(unsigned,b);}
#define WAIT_BAR(N) asm volatile("s_waitcnt vmcnt(" #N ") lgkmcnt(0)\n\ts_barrier":::"memory")

__device__ __forceinline__ void qkt(f32x16&p0,f32x16&p1,const char*Kslot,const bf16x8*qr,const f32x16&negm,int r32,int hi){
  const char*kb=Kslot+hi*1024+r32*16;
  #pragma unroll
  for(int d0=0;d0<4;++d0){
    const bf16x8 b0=*reinterpret_cast<const bf16x8*>(kb+d0*2048);
    const bf16x8 b1=*reinterpret_cast<const bf16x8*>(kb+d0*2048+512);
    if(d0==0){p0=__builtin_amdgcn_mfma_f32_32x32x16_bf16(b0,qr[0],negm,0,0,0);p1=__builtin_amdgcn_mfma_f32_32x32x16_bf16(b1,qr[0],negm,0,0,0);}
    else{p0=__builtin_amdgcn_mfma_f32_32x32x16_bf16(b0,qr[d0],p0,0,0,0);p1=__builtin_amdgcn_mfma_f32_32x32x16_bf16(b1,qr[d0],p1,0,0,0);}}
}
typedef __attribute__((address_space(3))) const char* lds_cptr;
typedef short v4i16_t __attribute__((ext_vector_type(4)));
__device__ __forceinline__ void kload8(bf16x8*kf,lds_cptr kp){
  kf[0]=*(const __attribute__((address_space(3))) bf16x8*)(kp);      kf[1]=*(const __attribute__((address_space(3))) bf16x8*)(kp+512);
  kf[2]=*(const __attribute__((address_space(3))) bf16x8*)(kp+2048); kf[3]=*(const __attribute__((address_space(3))) bf16x8*)(kp+2560);
  kf[4]=*(const __attribute__((address_space(3))) bf16x8*)(kp+4096); kf[5]=*(const __attribute__((address_space(3))) bf16x8*)(kp+4608);
  kf[6]=*(const __attribute__((address_space(3))) bf16x8*)(kp+6144); kf[7]=*(const __attribute__((address_space(3))) bf16x8*)(kp+6656);
}
__device__ __forceinline__ void kload2(bf16x8*kf,lds_cptr kp,int j){ kf[2*j]=*(const __attribute__((address_space(3))) bf16x8*)(kp+j*2048); kf[2*j+1]=*(const __attribute__((address_space(3))) bf16x8*)(kp+j*2048+512); }
__device__ __forceinline__ s16x4 vtr(lds_cptr p){ return __builtin_bit_cast(s16x4,__builtin_amdgcn_ds_read_tr16_b64_v4i16((__attribute__((address_space(3))) v4i16_t*)p)); }
__device__ __forceinline__ float rowmax(const f32x16&p0,const f32x16&p1){
  float a=max3f(p0[0],p0[1],p1[0]),b=max3f(p0[2],p0[3],p1[1]);a=max3f(a,p1[2],p1[3]);
  #pragma unroll
  for(int r=4;r<16;r+=4){a=max3f(a,p0[r],p0[r+1]);b=max3f(b,p0[r+2],p0[r+3]);a=max3f(a,p1[r],p1[r+1]);b=max3f(b,p1[r+2],p1[r+3]);}
  const float m=max2f(a,b);
  auto rr=__builtin_amdgcn_permlane32_swap(__float_as_uint(m),__float_as_uint(m),false,false);
  return max2f(__uint_as_float(rr[0]),__uint_as_float(rr[1]));
}
__device__ __forceinline__ void pv(f32x16*o,int vb,bf16x8 pa0,bf16x8 pa1,bf16x8 pa2,bf16x8 pa3){
  #pragma unroll
  for(int d0=0;d0<2;++d0){s16x4 lo[4],hi[4];
    #pragma unroll
    for(int ks=0;ks<4;++ks){
      asm volatile("ds_read_b64_tr_b16 %0,%1 offset:%c2":"=&v"(lo[ks]):"v"(vb),"i"(d0*4096+ks*1024):"memory");
      asm volatile("ds_read_b64_tr_b16 %0,%1 offset:%c2":"=&v"(hi[ks]):"v"(vb),"i"(d0*4096+ks*1024+512):"memory");}
    asm volatile("s_waitcnt lgkmcnt(0)":::"memory");SBAR();
    #define PK(k) (bf16x8){lo[k][0],lo[k][1],lo[k][2],lo[k][3],hi[k][0],hi[k][1],hi[k][2],hi[k][3]}
    o[d0]=__builtin_amdgcn_mfma_f32_32x32x16_bf16(pa0,PK(0),o[d0],0,0,0);
    o[d0]=__builtin_amdgcn_mfma_f32_32x32x16_bf16(pa1,PK(1),o[d0],0,0,0);
    o[d0]=__builtin_amdgcn_mfma_f32_32x32x16_bf16(pa2,PK(2),o[d0],0,0,0);
    o[d0]=__builtin_amdgcn_mfma_f32_32x32x16_bf16(pa3,PK(3),o[d0],0,0,0);
    #undef PK
  }
}

__device__ __forceinline__ void pv2(f32x16&oa,f32x16&ob,int vb,bf16x8 pa0,bf16x8 pa1,bf16x8 pa2,bf16x8 pa3){
  #pragma unroll
  for(int d0=0;d0<2;++d0){s16x4 lo[4],hi[4];
    #pragma unroll
    for(int ks=0;ks<4;++ks){
      asm volatile("ds_read_b64_tr_b16 %0,%1 offset:%c2":"=&v"(lo[ks]):"v"(vb),"i"(d0*4096+ks*1024):"memory");
      asm volatile("ds_read_b64_tr_b16 %0,%1 offset:%c2":"=&v"(hi[ks]):"v"(vb),"i"(d0*4096+ks*1024+512):"memory");}
    asm volatile("s_waitcnt lgkmcnt(0)":::"memory");SBAR();
    #define PK(k) (bf16x8){lo[k][0],lo[k][1],lo[k][2],lo[k][3],hi[k][0],hi[k][1],hi[k][2],hi[k][3]}
    f32x16 acc=d0?ob:oa;
    acc=__builtin_amdgcn_mfma_f32_32x32x16_bf16(pa0,PK(0),acc,0,0,0);
    acc=__builtin_amdgcn_mfma_f32_32x32x16_bf16(pa1,PK(1),acc,0,0,0);
    acc=__builtin_amdgcn_mfma_f32_32x32x16_bf16(pa2,PK(2),acc,0,0,0);
    acc=__builtin_amdgcn_mfma_f32_32x32x16_bf16(pa3,PK(3),acc,0,0,0);
    if(d0)ob=acc;else oa=acc;
    #undef PK
  }
}
#ifndef ATTN_STORE16
#define ATTN_STORE16(p,v) (*(u32x4*)(p)=(v))
#endif
template<int THRL> __device__ __forceinline__ void attn_unit(int qb,const bf16*Qh,const bf16*__restrict__ Kh,const bf16*__restrict__ Vh,bf16*Oh,char*shm,unsigned selmask){
  int tid_=threadIdx.x; asm volatile("":"+v"(tid_)); const int tid=tid_,lane=tid&63,r32=lane&31,hi=lane>>5; const int wid=__builtin_amdgcn_readfirstlane(tid>>6);
  const int q0=qb*QB;
  const bf16*Qw=Qh+(long)(q0+wid*QBLK)*PQ;
  const unsigned lds0=(unsigned)(uintptr_t)shm;
  float*wsf=(float*)(shm+LDS_WS)+wid*64;
  const bf16*ksrc=Kh+(long)lane*PQ+wid*8;
  const bf16*vsrc=Vh+(long)(16*(wid&3)+(lane>>2))*PQ+(wid>>2)*32+(lane&3)*8;
  const unsigned kdst=lds0+LDS_K+wid*1024, vdst=lds0+LDS_V+wid*1024;
  #define DMA_K(t,slot) glds16(ksrc+(long)(t)*KVBLK*PQ,(unsigned)__builtin_amdgcn_readfirstlane(kdst+(slot)))
  #define DMA_V(t,slot) glds16(vsrc+(long)(t)*KVBLK*PQ,(unsigned)__builtin_amdgcn_readfirstlane(vdst+(slot)))
  const int vb0=(int)(lds0+LDS_V)+((lane>>4)&1)*32+(lane&3)*8+(4*hi+((lane&15)>>2))*64;
  const char*Kbase=shm+LDS_K; bf16x8 kf[8];
  const lds_cptr shm3=(lds_cptr)shm; const lds_cptr kp0=shm3+LDS_K+hi*1024+r32*16; const lds_cptr vp0=shm3+LDS_V+((lane>>4)&1)*32+(lane&3)*8+(4*hi+((lane&15)>>2))*64;
  const int NT=(q0+QB)/KVBLK;
  DMA_K(0,0);DMA_V(0,0);DMA_K(1,SLOTB);
  bf16x8 qr[4];
  #pragma unroll
  for(int d0=0;d0<4;++d0)qr[d0]=*reinterpret_cast<const bf16x8*>(&Qw[(long)r32*PQ+d0*16+hi*8]);
  float l_reg=0.f;f32x16 o[2];o[0]=f32x16{};o[1]=f32x16{};f32x16 negm;
  #define SETBIAS(t) do{ const float bv_=((selmask>>((t)>>2))&1u)?0.f:-INFINITY; _Pragma("unroll") for(int r_=0;r_<16;++r_)negm[r_]=bv_; asm volatile("":"+v"(negm)); }while(0)
  SETBIAS(0);
  const int qrel=wid*QBLK+r32;
  #define CMASK(P0,P1,t) do{int jb_=(t)-(NT-4); if(jb_>=0)cmask(P0,P1,jb_,qrel,hi);}while(0)
  #define START(P0,P1) do{ _Pragma("unroll") for(int r=0;r<16;++r)P0[r]=__builtin_amdgcn_exp2f(P0[r]); }while(0)
  #define RESC() do{}while(0)
  f32x16 pA0,pA1,pB0,pB1;
  int sl_prev=0,sl_cur=0,sl_next=SLOTB;
  #define ROT() do{sl_prev=sl_cur;sl_cur=sl_next;sl_next=(sl_next==(NSLOT-1)*SLOTB)?0:sl_next+SLOTB;}while(0)
  DMA_K(2,2*SLOTB);
  WAIT_BAR(3);
  qkt(pA0,pA1,Kbase,qr,negm,r32,hi);asm volatile("s_nop 15\n\ts_nop 7":"+v"(pA0),"+v"(pA1));CMASK(pA0,pA1,0);
  START(pA0,pA1);
  _Pragma("unroll") for(int r=0;r<16;++r)pA1[r]=__builtin_amdgcn_exp2f(pA1[r]);
  WAIT_BAR(0);
  DMA_K(3,0);DMA_V(1,SLOTB);
  ROT();
  kload8(kf,kp0+sl_cur);
  WAIT_BAR(2);
  s16x4 vlo[8],vhi[8]; u32x4 pw0,pw1,pw2,pw3;
  #define PKW(P,B) cvtpk_s(P[B],P[B+1])
  #define PAF(k) __builtin_bit_cast(bf16x8,pw##k)
  #define VFR(i) (bf16x8){vlo[i][0],vlo[i][1],vlo[i][2],vlo[i][3],vhi[i][0],vhi[i][1],vhi[i][2],vhi[i][3]}
  #define PIN(x) asm volatile("":"+v"(x))
  #define MX3(a,b,c) __builtin_fmaxf(__builtin_fmaxf((a),(b)),(c))
  #define GAPA(MF,A0,A1,A2,A3,W0,W1,PW) do{ MF; sacc+=A0; sacc+=A1; sacc+=A2; sacc+=A3; PIN(sacc); W0; W1; PIN(PW); SBAR(); }while(0)
  #define EX(v) __builtin_amdgcn_exp2f(v)
  #define GAPB(MF,X,B) do{ MF; X[B]=EX(X[B]); X[B+1]=EX(X[B+1]); X[B+2]=EX(X[B+2]); X[B+3]=EX(X[B+3]); PIN(X); SBAR(); }while(0)
  #define VRD(i) do{ vlo[i]=vtr(vp_+(((i)>>2)*4096+((i)&3)*1024)); vhi[i]=vtr(vp_+(((i)>>2)*4096+((i)&3)*1024+512)); }while(0)
  #define KRD(G,j) do{ if(G){ kload2(kf,kp0+sl_next,j); SBAR(); } }while(0)
  #define STEP(C0,C1,P0,P1,t,GK,GV,GL) do{ SBAR(); if((((t))&3)==0){ SETBIAS(t); } SBAR(); \
    const lds_cptr vp_=vp0+sl_prev; \
    VRD(0); SBAR(); float sacc=(P0[0]+P0[1]); \
    GAPA(C0=__builtin_amdgcn_mfma_f32_32x32x16_bf16(kf[0],qr[0],negm,0,0,0), P0[2],P0[3],P0[4],P0[5],     pw0[0]=PKW(P0,0), pw0[1]=PKW(P0,2), pw0); \
    VRD(4); SBAR(); GAPA(C1=__builtin_amdgcn_mfma_f32_32x32x16_bf16(kf[1],qr[0],negm,0,0,0), P0[6],P0[7],P0[8],P0[9],     pw0[2]=PKW(P0,4), pw0[3]=PKW(P0,6), pw0); \
    VRD(1); SBAR(); GAPA(C0=__builtin_amdgcn_mfma_f32_32x32x16_bf16(kf[2],qr[1],C0,0,0,0),   P0[10],P0[11],P0[12],P0[13], pw1[0]=PKW(P0,8), pw1[1]=PKW(P0,10), pw1); \
    VRD(5); SBAR(); GAPA(C1=__builtin_amdgcn_mfma_f32_32x32x16_bf16(kf[3],qr[1],C1,0,0,0),   P0[14],P0[15],P1[0],P1[1],   pw1[2]=PKW(P0,12),pw1[3]=PKW(P0,14), pw1); \
    VRD(2); SBAR(); GAPA(C0=__builtin_amdgcn_mfma_f32_32x32x16_bf16(kf[4],qr[2],C0,0,0,0),   P1[2],P1[3],P1[4],P1[5],     pw2[0]=PKW(P1,0), pw2[1]=PKW(P1,2), pw2); \
    VRD(6); SBAR(); GAPA(C1=__builtin_amdgcn_mfma_f32_32x32x16_bf16(kf[5],qr[2],C1,0,0,0),   P1[6],P1[7],P1[8],P1[9],     pw2[2]=PKW(P1,4), pw2[3]=PKW(P1,6), pw2); \
    VRD(3); SBAR(); GAPA(C0=__builtin_amdgcn_mfma_f32_32x32x16_bf16(kf[6],qr[3],C0,0,0,0),   P1[10],P1[11],P1[12],P1[13], pw3[0]=PKW(P1,8), pw3[1]=PKW(P1,10), pw3); \
    VRD(7); SBAR(); GAPA(C1=__builtin_amdgcn_mfma_f32_32x32x16_bf16(kf[7],qr[3],C1,0,0,0),   P1[14],P1[15],0.f,0.f,       pw3[2]=PKW(P1,12),pw3[3]=PKW(P1,14), pw3); \
    l_reg+=sacc; \
    if(GK){DMA_K((t)+3,sl_cur);} if(GV){DMA_V((t)+1,sl_next);} \
    CMASK(C0,C1,t); \
    SBAR(); \
    GAPB(o[0]=__builtin_amdgcn_mfma_f32_32x32x16_bf16(PAF(0),VFR(0),o[0],0,0,0), C0,0); \
    GAPB(o[1]=__builtin_amdgcn_mfma_f32_32x32x16_bf16(PAF(0),VFR(4),o[1],0,0,0), C0,4); \
    KRD(GL,0); GAPB(o[0]=__builtin_amdgcn_mfma_f32_32x32x16_bf16(PAF(1),VFR(1),o[0],0,0,0), C0,8); \
    KRD(GL,1); GAPB(o[1]=__builtin_amdgcn_mfma_f32_32x32x16_bf16(PAF(1),VFR(5),o[1],0,0,0), C0,12); \
    KRD(GL,2); GAPB(o[0]=__builtin_amdgcn_mfma_f32_32x32x16_bf16(PAF(2),VFR(2),o[0],0,0,0), C1,0); \
    KRD(GL,3); GAPB(o[1]=__builtin_amdgcn_mfma_f32_32x32x16_bf16(PAF(2),VFR(6),o[1],0,0,0), C1,4); \
    GAPB(o[0]=__builtin_amdgcn_mfma_f32_32x32x16_bf16(PAF(3),VFR(3),o[0],0,0,0), C1,8); \
    GAPB(o[1]=__builtin_amdgcn_mfma_f32_32x32x16_bf16(PAF(3),VFR(7),o[1],0,0,0), C1,12); \
    }while(0)
  int t=1;
  #undef CMASK
  #define CMASK(P0,P1,t) do{}while(0)
  for(;t+5<NT;t+=2){
    STEP(pB0,pB1,pA0,pA1,t,true,true,true);     WAIT_BAR(2); RESC(); ROT();
    STEP(pA0,pA1,pB0,pB1,t+1,true,true,true);   WAIT_BAR(2); RESC(); ROT();
  }
  #undef CMASK
  #define CMASK(P0,P1,t) do{int jb_=(t)-(NT-4); if(jb_>=0)cmask(P0,P1,jb_,qrel,hi);}while(0)
  #define ENDW(tt) do{ if((tt)+3<NT){WAIT_BAR(2);} else if((tt)+2<NT){WAIT_BAR(1);} else {WAIT_BAR(0);} }while(0)
  for(;t+1<NT;t+=2){
    STEP(pB0,pB1,pA0,pA1,t,(t+3<NT),(t+1<NT),(t+1<NT));       ENDW(t);   RESC(); ROT();
    STEP(pA0,pA1,pB0,pB1,t+1,(t+4<NT),(t+2<NT),(t+2<NT));     ENDW(t+1); RESC(); ROT();
  }
  STEP(pB0,pB1,pA0,pA1,NT-1,false,false,false); RESC();
  { float sacc=pB0[0]+pB0[1]; _Pragma("unroll") for(int r=2;r<16;++r)sacc+=pB0[r]; _Pragma("unroll") for(int r=0;r<16;++r)sacc+=pB1[r]; l_reg+=sacc;
    pw0=(u32x4){PKW(pB0,0),PKW(pB0,2),PKW(pB0,4),PKW(pB0,6)};pw1=(u32x4){PKW(pB0,8),PKW(pB0,10),PKW(pB0,12),PKW(pB0,14)};pw2=(u32x4){PKW(pB1,0),PKW(pB1,2),PKW(pB1,4),PKW(pB1,6)};pw3=(u32x4){PKW(pB1,8),PKW(pB1,10),PKW(pB1,12),PKW(pB1,14)};
    SBAR(); pv(o,vb0+sl_cur,PAF(0),PAF(1),PAF(2),PAF(3)); }
  #undef PKW
  #undef PAF
  #undef VFR
  #undef PIN
  #undef MX3
  #undef GAPA
  #undef GAPB
  #undef EX
  #undef VRD
  #undef KRD
  #undef STEP
  #undef ENDW
  {auto rr=__builtin_amdgcn_permlane32_swap(__float_as_uint(l_reg),__float_as_uint(l_reg),false,false);l_reg=__uint_as_float(rr[0])+__uint_as_float(rr[1]);}
  if(hi==0)wsf[32+r32]=l_reg;asm volatile("s_waitcnt lgkmcnt(0)":::"memory");
  float rli[16];
  #pragma unroll
  for(int r=0;r<16;++r)rli[r]=__builtin_amdgcn_rcpf(wsf[32+crow(r,hi)]);
  bf16*Ow=Oh+(long)(q0+wid*QBLK)*PO;
  { bf16*stg=(bf16*)(shm+LDS_OST)+wid*2048;
    #pragma unroll
    for(int r=0;r<16;++r){const int orow=crow(r,hi);
      #pragma unroll
      for(int d0=0;d0<2;++d0)stg[orow*64+d0*32+r32]=__float2bfloat16(o[d0][r]*rli[r]);}
    asm volatile("s_waitcnt lgkmcnt(0)":::"memory");
    #pragma unroll
    for(int i=0;i<4;++i){const int row=i*8+(lane>>3),ch=lane&7; const u32x4 v=*(const u32x4*)(stg+row*64+ch*8); ATTN_STORE16(Ow+(long)row*PO+ch*8,v);} }
  asm volatile("s_waitcnt lgkmcnt(0)\n\ts_barrier":::"memory");
  #undef DMA_K
  #undef DMA_V
  #undef CMASK
  #undef SETBIAS
  #undef START
  #undef RESC
  #undef ROT
}

constexpr int DV_LDS_WS=LDS_V+NSLOT*2*SLOTB, DV_LDS_OST=DV_LDS_WS+NW*64*4, DV_LDS_BYTES=DV_LDS_OST+NW*4096;
__device__ __forceinline__ void attn_unit_dv(int qb,const bf16*Qh,const bf16*__restrict__ Kh,const bf16*__restrict__ Vh,bf16*Oh,char*shm){
  int tid_=threadIdx.x; asm volatile("":"+v"(tid_)); const int tid=tid_,lane=tid&63,r32=lane&31,hi=lane>>5; const int wid=__builtin_amdgcn_readfirstlane(tid>>6);
  const int q0=qb*QB;
  const bf16*Qw=Qh+(long)(q0+wid*QBLK)*PQ;
  const unsigned lds0=(unsigned)(uintptr_t)shm;
  float*wsf=(float*)(shm+DV_LDS_WS)+wid*64;
  const bf16*ksrc=Kh+(long)lane*PQ+wid*8;
  const bf16*vsrc=Vh+(long)(16*(wid&3)+(lane>>2))*PQ+(wid>>2)*32+(lane&3)*8;
  const unsigned kdst=lds0+LDS_K+wid*1024, vdst=lds0+LDS_V+wid*1024;
  #define DMA_K(t,slot) glds16(ksrc+(long)(t)*KVBLK*PQ,(unsigned)__builtin_amdgcn_readfirstlane(kdst+(slot)))
  #define DMA_V(t,slot) do{ glds16(vsrc+(long)(t)*KVBLK*PQ,(unsigned)__builtin_amdgcn_readfirstlane(vdst+2*(slot))); glds16(vsrc+(long)SEQ*64+(long)(t)*KVBLK*PQ,(unsigned)__builtin_amdgcn_readfirstlane(vdst+2*(slot)+8192)); }while(0)
  const int vb0=(int)(lds0+LDS_V)+((lane>>4)&1)*32+(lane&3)*8+(4*hi+((lane&15)>>2))*64;
  const char*Kbase=shm+LDS_K; bf16x8 kf[8];
  const lds_cptr shm3=(lds_cptr)shm; const lds_cptr kp0=shm3+LDS_K+hi*1024+r32*16; const lds_cptr vp0=shm3+LDS_V+((lane>>4)&1)*32+(lane&3)*8+(4*hi+((lane&15)>>2))*64;
  const int NT=(q0+QB)/KVBLK;
  if(wid>=4)__builtin_amdgcn_s_setprio(1);
  DMA_K(0,0);DMA_V(0,0);DMA_K(1,SLOTB);
  bf16x8 qr[4];
  #pragma unroll
  for(int d0=0;d0<4;++d0)qr[d0]=*reinterpret_cast<const bf16x8*>(&Qw[(long)r32*PQ+d0*16+hi*8]);
  float l_reg=0.f;f32x16 o[4];o[0]=f32x16{};o[1]=f32x16{};o[2]=f32x16{};o[3]=f32x16{};const f32x16 z16=f32x16{};
  const int qrel=wid*QBLK+r32;
  #define CMASK(P0,P1,t) do{int jb_=(t)-(NT-4); if(jb_>=0)cmask(P0,P1,jb_,qrel,hi);}while(0)
  f32x16 pA0,pA1;
  int sl_prev=0,sl_cur=0,sl_next=SLOTB;
  #define ROT() do{sl_prev=sl_cur;sl_cur=sl_next;sl_next=(sl_next==(NSLOT-1)*SLOTB)?0:sl_next+SLOTB;}while(0)
  u32x4 pw0,pw1,pw2,pw3;
  #define PKW(P,B) cvtpk_s(P[B],P[B+1])
  #define PAF(k) __builtin_bit_cast(bf16x8,pw##k)
  #define PIN(x) asm volatile("":"+v"(x))
  #define EX(v) __builtin_amdgcn_exp2f(v)
  #define PACKP(P0,P1) do{ float sa_=(P0[0]+P0[1])+(P0[2]+P0[3]), sb_=(P1[0]+P1[1])+(P1[2]+P1[3]); \
    _Pragma("unroll") for(int r_=4;r_<16;r_+=4){ sa_+=(P0[r_]+P0[r_+1])+(P0[r_+2]+P0[r_+3]); sb_+=(P1[r_]+P1[r_+1])+(P1[r_+2]+P1[r_+3]); } l_reg+=sa_+sb_; \
    pw0=(u32x4){PKW(P0,0),PKW(P0,2),PKW(P0,4),PKW(P0,6)};pw1=(u32x4){PKW(P0,8),PKW(P0,10),PKW(P0,12),PKW(P0,14)};pw2=(u32x4){PKW(P1,0),PKW(P1,2),PKW(P1,4),PKW(P1,6)};pw3=(u32x4){PKW(P1,8),PKW(P1,10),PKW(P1,12),PKW(P1,14)}; PIN(pw0);PIN(pw1);PIN(pw2);PIN(pw3);PIN(l_reg); }while(0)
  DMA_K(2,2*SLOTB);
  WAIT_BAR(3);
  qkt(pA0,pA1,Kbase,qr,z16,r32,hi);CMASK(pA0,pA1,0);
  _Pragma("unroll") for(int r=0;r<16;++r){pA0[r]=EX(pA0[r]);pA1[r]=EX(pA1[r]);}
  PACKP(pA0,pA1);
  WAIT_BAR(1);
  DMA_K(3,0);DMA_V(1,SLOTB);
  ROT();
  kload8(kf,kp0+sl_cur);
  WAIT_BAR(3);
  s16x4 valo[2][4],vahi[2][4];
  #define VLD1(buf,ks,db) do{ valo[buf][db]=vtr(vp_+((db)*4096+(ks)*1024)); vahi[buf][db]=vtr(vp_+((db)*4096+(ks)*1024+512)); }while(0)
  #define VF(buf,db) (bf16x8){valo[buf][db][0],valo[buf][db][1],valo[buf][db][2],valo[buf][db][3],vahi[buf][db][0],vahi[buf][db][1],vahi[buf][db][2],vahi[buf][db][3]}
  #define KRD(G,j) do{ if(G){ kload2(kf,kp0+sl_next,j); SBAR(); } }while(0)
  #define QK(C,kk,qq,Cin) do{ C=__builtin_amdgcn_mfma_f32_32x32x16_bf16(kf[kk],qr[qq],Cin,0,0,0); SBAR(); }while(0)
  #define MFO(db,ks,buf) o[db]=__builtin_amdgcn_mfma_f32_32x32x16_bf16(PAF(ks),VF(buf,db),o[db],0,0,0)
  #define G4(ks,buf,X,B,DOPREV,PX,PB,PWP) do{ \
    MFO(0,ks,buf); X[B]=EX(X[B]); X[B+1]=EX(X[B+1]); if(DOPREV){ sacc+=PX[PB]; sacc+=PX[PB+1]; PWP[0]=PKW(PX,PB); } PIN(X); SBAR(); \
    MFO(1,ks,buf); X[B+2]=EX(X[B+2]); X[B+3]=EX(X[B+3]); if(DOPREV){ sacc+=PX[PB+2]; sacc+=PX[PB+3]; PWP[1]=PKW(PX,PB+2); } PIN(X); SBAR(); \
    MFO(2,ks,buf); X[B+4]=EX(X[B+4]); X[B+5]=EX(X[B+5]); if(DOPREV){ sacc+=PX[PB+4]; sacc+=PX[PB+5]; PWP[2]=PKW(PX,PB+4); } PIN(X); SBAR(); \
    MFO(3,ks,buf); X[B+6]=EX(X[B+6]); X[B+7]=EX(X[B+7]); if(DOPREV){ sacc+=PX[PB+6]; sacc+=PX[PB+7]; PWP[3]=PKW(PX,PB+6); PIN(PWP); } PIN(X); PIN(sacc); SBAR(); \
    }while(0)
  #define STEP(C0,C1,t,GK,GV,GL) do{ SBAR(); \
    const lds_cptr vp_=vp0+2*sl_prev; float sacc=0.f; \
    VLD1(0,0,0); SBAR(); QK(C0,0,0,z16); \
    VLD1(0,0,1); SBAR(); QK(C1,1,0,z16); \
    VLD1(0,0,2); SBAR(); QK(C0,2,1,C0); \
    VLD1(0,0,3); SBAR(); QK(C1,3,1,C1); \
    VLD1(1,1,0); SBAR(); QK(C0,4,2,C0); \
    VLD1(1,1,1); SBAR(); QK(C1,5,2,C1); \
    VLD1(1,1,2); SBAR(); QK(C0,6,3,C0); \
    VLD1(1,1,3); SBAR(); QK(C1,7,3,C1); \
    if(GK){DMA_K((t)+3,sl_cur);} if(GV){DMA_V((t)+1,sl_next);} \
    CMASK(C0,C1,t); \
    SBAR(); \
    G4(0,0,C0,0,false,C0,0,pw0); \
    VLD1(0,2,0); VLD1(0,2,1); VLD1(0,2,2); VLD1(0,2,3); SBAR(); KRD(GL,0); KRD(GL,1); \
    G4(1,1,C0,8,true,C0,0,pw0); \
    VLD1(1,3,0); VLD1(1,3,1); VLD1(1,3,2); VLD1(1,3,3); SBAR(); KRD(GL,2); KRD(GL,3); \
    G4(2,0,C1,0,true,C0,8,pw1); \
    G4(3,1,C1,8,true,C1,0,pw2); \
    sacc+=(C1[8]+C1[9])+(C1[10]+C1[11]); sacc+=(C1[12]+C1[13])+(C1[14]+C1[15]); l_reg+=sacc; \
    pw3=(u32x4){PKW(C1,8),PKW(C1,10),PKW(C1,12),PKW(C1,14)}; PIN(pw3); PIN(l_reg); PIN(o[0]);PIN(o[1]);PIN(o[2]);PIN(o[3]); SBAR(); \
    }while(0)
  int t=1;
  #undef CMASK
  #define CMASK(P0,P1,t) do{}while(0)
  for(;t+5<NT;t+=2){
    STEP(pA0,pA1,t,true,true,true);     WAIT_BAR(3); ROT();
    STEP(pA0,pA1,t+1,true,true,true);   WAIT_BAR(3); ROT();
  }
  #undef CMASK
  #define CMASK(P0,P1,t) do{int jb_=(t)-(NT-4); if(jb_>=0)cmask(P0,P1,jb_,qrel,hi);}while(0)
  #define ENDW(tt) do{ if((tt)+3<NT){WAIT_BAR(3);} else if((tt)+2<NT){WAIT_BAR(2);} else {WAIT_BAR(0);} }while(0)
  for(;t+1<NT;t+=2){
    STEP(pA0,pA1,t,(t+3<NT),(t+1<NT),(t+1<NT));       ENDW(t);   ROT();
    STEP(pA0,pA1,t+1,(t+4<NT),(t+2<NT),(t+2<NT));     ENDW(t+1); ROT();
  }
  STEP(pA0,pA1,NT-1,false,false,false);
  SBAR(); pv2(o[0],o[1],vb0+2*sl_cur,PAF(0),PAF(1),PAF(2),PAF(3)); pv2(o[2],o[3],vb0+2*sl_cur+8192,PAF(0),PAF(1),PAF(2),PAF(3));
  #undef PKW
  #undef PAF
  #undef PIN
  #undef EX
  #undef VLD1
  #undef VF
  #undef MFO
  #undef G4
  #undef KRD
  #undef QK
  #undef STEP
  #undef ENDW
  #undef PACKP
  {auto rr=__builtin_amdgcn_permlane32_swap(__float_as_uint(l_reg),__float_as_uint(l_reg),false,false);l_reg=__uint_as_float(rr[0])+__uint_as_float(rr[1]);}
  if(hi==0)wsf[32+r32]=l_reg;asm volatile("s_waitcnt lgkmcnt(0)":::"memory");
  float rli[16];
  #pragma unroll
  for(int r=0;r<16;++r)rli[r]=__builtin_amdgcn_rcpf(wsf[32+crow(r,hi)]);
  bf16*Ow=Oh+(long)(q0+wid*QBLK)*PO;
  { bf16*stg=(bf16*)(shm+DV_LDS_OST)+wid*2048;
    #pragma unroll
    for(int hh=0;hh<2;++hh){
      #pragma unroll
      for(int r=0;r<16;++r){const int orow=crow(r,hi);
        #pragma unroll
        for(int d0=0;d0<2;++d0)stg[orow*64+d0*32+r32]=__float2bfloat16(o[2*hh+d0][r]*rli[r]);}
      asm volatile("s_waitcnt lgkmcnt(0)":::"memory");
      #pragma unroll
      for(int i=0;i<4;++i){const int row=i*8+(lane>>3),ch=lane&7; const u32x4 v=*(const u32x4*)(stg+row*64+ch*8); ATTN_STORE16(Ow+(long)row*PO+hh*64+ch*8,v);}
      asm volatile("s_waitcnt lgkmcnt(0)":::"memory"); } }
  __builtin_amdgcn_s_setprio(0);
  asm volatile("s_waitcnt lgkmcnt(0)\n\ts_barrier":::"memory");
  #undef DMA_K
  #undef DMA_V
  #undef CMASK
  #undef ROT
}

__device__ __forceinline__ void pv2c(f32x16&oa,f32x16&ob,lds_cptr vb,bf16x8 pa0,bf16x8 pa1,bf16x8 pa2,bf16x8 pa3){
  #pragma unroll
  for(int d0=0;d0<2;++d0){ s16x4 lo[4],hi[4];
    #pragma unroll
    for(int ks=0;ks<4;++ks){ lo[ks]=vtr(vb+(d0*4096+ks*1024)); hi[ks]=vtr(vb+(d0*4096+ks*1024+512)); }
    #define PK(k) (bf16x8){lo[k][0],lo[k][1],lo[k][2],lo[k][3],hi[k][0],hi[k][1],hi[k][2],hi[k][3]}
    f32x16 acc=d0?ob:oa;
    acc=__builtin_amdgcn_mfma_f32_32x32x16_bf16(pa0,PK(0),acc,0,0,0);
    acc=__builtin_amdgcn_mfma_f32_32x32x16_bf16(pa1,PK(1),acc,0,0,0);
    acc=__builtin_amdgcn_mfma_f32_32x32x16_bf16(pa2,PK(2),acc,0,0,0);
    acc=__builtin_amdgcn_mfma_f32_32x32x16_bf16(pa3,PK(3),acc,0,0,0);
    if(d0)ob=acc;else oa=acc;
    #undef PK
  }
}
constexpr int MB_K=0, MB_V=32768, MB_WS=65536, MB_OST=MB_WS+NW*256, MB_END=MB_OST+NW*4096;
__device__ __forceinline__ void moba_load_block(const bf16*Kb,const bf16*Vb,char*shm){
  int tid_=threadIdx.x; asm volatile("":"+v"(tid_)); const int lane=tid_&63; const int wid=__builtin_amdgcn_readfirstlane(tid_>>6);
  const unsigned lds0=(unsigned)(uintptr_t)shm;
  const bf16*ksrc=Kb+(long)lane*PQ+wid*8;
  const bf16*vsrc=Vb+(long)(16*(wid&3)+(lane>>2))*PQ+(wid>>2)*32+(lane&3)*8;
  #pragma unroll
  for(int t=0;t<4;++t){ glds16(ksrc+(long)t*KVBLK*PQ,(unsigned)__builtin_amdgcn_readfirstlane(lds0+MB_K+t*8192+wid*1024)); glds16(vsrc+(long)t*KVBLK*PQ,(unsigned)__builtin_amdgcn_readfirstlane(lds0+MB_V+t*8192+wid*1024)); }
  asm volatile("s_waitcnt vmcnt(0) lgkmcnt(0)\n\ts_barrier":::"memory");
}
struct MobaQ { bf16x8 f[4]; };
__device__ __forceinline__ MobaQ moba_qload(const bf16*Qh,int q){ int tid_=threadIdx.x; asm volatile("":"+v"(tid_)); const int hi=(tid_&63)>>5; MobaQ r;
  #pragma unroll
  for(int d0=0;d0<4;++d0)r.f[d0]=*reinterpret_cast<const bf16x8*>(&Qh[(long)q*PQ+d0*16+hi*8]); return r; }
template<bool CAUSAL> __device__ __forceinline__ void moba_task(const MobaQ&Q,int qrel,char*shm){
  int tid_=threadIdx.x; asm volatile("":"+v"(tid_)); const int lane=tid_&63,r32=lane&31,hi=lane>>5; const int wid=__builtin_amdgcn_readfirstlane(tid_>>6);
  const unsigned lds0=(unsigned)(uintptr_t)shm;
  float*wsf=(float*)(shm+MB_WS)+wid*64;
  const lds_cptr vb0=(lds_cptr)shm+MB_V+((lane>>4)&1)*32+(lane&3)*8+(4*hi+((lane&15)>>2))*64;
  f32x16 o[2];o[0]=f32x16{};o[1]=f32x16{};float l_reg=0.f;const f32x16 z16=f32x16{};
  #pragma unroll
  for(int t=0;t<4;++t){
    const int wrow0=__builtin_amdgcn_readfirstlane(qrel)&~31;
    if(CAUSAL&&t*64>wrow0+31)continue;
    f32x16 p0,p1;
    qkt(p0,p1,shm+MB_K+t*8192,Q.f,z16,r32,hi);
    if(CAUSAL&&t*64+63>wrow0)cmask(p0,p1,t,qrel,hi);
    #pragma unroll
    for(int r=0;r<16;++r){p0[r]=__builtin_amdgcn_exp2f(p0[r]);p1[r]=__builtin_amdgcn_exp2f(p1[r]);}
    float sa=(p0[0]+p0[1])+(p0[2]+p0[3]),sb=(p1[0]+p1[1])+(p1[2]+p1[3]);
    #pragma unroll
    for(int r=4;r<16;r+=4){sa+=(p0[r]+p0[r+1])+(p0[r+2]+p0[r+3]);sb+=(p1[r]+p1[r+1])+(p1[r+2]+p1[r+3]);}
    l_reg+=sa+sb;
    const u32x4 w0={cvtpk_s(p0[0],p0[1]),cvtpk_s(p0[2],p0[3]),cvtpk_s(p0[4],p0[5]),cvtpk_s(p0[6],p0[7])},w1={cvtpk_s(p0[8],p0[9]),cvtpk_s(p0[10],p0[11]),cvtpk_s(p0[12],p0[13]),cvtpk_s(p0[14],p0[15])};
    const u32x4 w2={cvtpk_s(p1[0],p1[1]),cvtpk_s(p1[2],p1[3]),cvtpk_s(p1[4],p1[5]),cvtpk_s(p1[6],p1[7])},w3={cvtpk_s(p1[8],p1[9]),cvtpk_s(p1[10],p1[11]),cvtpk_s(p1[12],p1[13]),cvtpk_s(p1[14],p1[15])};
    pv2c(o[0],o[1],vb0+t*8192,__builtin_bit_cast(bf16x8,w0),__builtin_bit_cast(bf16x8,w1),__builtin_bit_cast(bf16x8,w2),__builtin_bit_cast(bf16x8,w3));
  }
  {auto rr=__builtin_amdgcn_permlane32_swap(__float_as_uint(l_reg),__float_as_uint(l_reg),false,false);l_reg=__uint_as_float(rr[0])+__uint_as_float(rr[1]);}
  if(hi==0)wsf[32+r32]=l_reg;asm volatile("s_waitcnt lgkmcnt(0)":::"memory");
  float rli[16];
  #pragma unroll
  for(int r=0;r<16;++r)rli[r]=__builtin_amdgcn_rcpf(wsf[32+crow(r,hi)]);
  bf16*stg=(bf16*)(shm+MB_OST)+wid*2048;
  #pragma unroll
  for(int r=0;r<16;++r){const int orow=crow(r,hi);
    #pragma unroll
    for(int d0=0;d0<2;++d0)stg[orow*64+d0*32+r32]=__float2bfloat16(o[d0][r]*rli[r]);}
  asm volatile("s_waitcnt lgkmcnt(0)":::"memory");
}
constexpr int ATTN_LDS_BYTES=LDS_BYTES;
#undef SBAR
#undef WAIT_BAR
}
#include <hip/hip_cooperative_groups.h>
namespace cg = cooperative_groups;
constexpr int NWAVES = 8;
constexpr int BATCH = 4, SEQ = 8192, DM = 1024, M = BATCH * SEQ, NPROJ = 3072, FFN = 2816, NGU = 2 * FFN;
constexpr size_t MiB = 1u << 20;
constexpr size_t WS_WIN = 0, WS_WOUT = 6 * MiB, WS_WGU = 8 * MiB, WS_WDN = 19 * MiB;
constexpr size_t WS_ROPE = 25 * MiB;
constexpr size_t WS_KMEAN = 27 * MiB;
constexpr size_t WS_GTAB = 27 * MiB + 512 * 1024;
constexpr size_t WS_BAR = 31 * MiB;
constexpr size_t WS_SS = 28 * MiB;
constexpr size_t WS_XN = 32 * MiB;
constexpr size_t WS_QKV = 96 * MiB;
constexpr size_t WS_OST = 288 * MiB;
constexpr size_t WS_MIX = 352 * MiB;
constexpr size_t WS_GL = 32 * MiB;
constexpr size_t WS_GC = 48 * MiB;
constexpr size_t WS_LP = 49 * MiB;
constexpr size_t WS_OP = 416 * MiB;
constexpr size_t WS_END = 512 * MiB;
constexpr int RING_BYTES = 131072, KM_OFF = 86016, LDS_BYTES = 147456;
#define GAS __attribute__((address_space(1)))
#define LAS __attribute__((address_space(3)))
typedef unsigned short bf16;
typedef unsigned v4u __attribute__((ext_vector_type(4)));
typedef float f32x4 __attribute__((ext_vector_type(4)));
#define LDS_WAIT() asm volatile("s_waitcnt lgkmcnt(0)" ::: "memory")
#define XB_TMO      128
#define XB_XCNT(j)  (256  + 64 * (j))
#define XB_XSUB(j)  (1280 + 64 * (j))
#define XB_XGEN(j)  (2304 + 64 * (j))
#define XB_TOP      3328
#define XB_TOPGEN   3392
#define XCD_BAR_WORDS 3456
#define XB_SPIN_CAP (1u << 18)

__device__ __forceinline__ unsigned xb_ld(unsigned* p)              { return __hip_atomic_load(p, __ATOMIC_RELAXED, __HIP_MEMORY_SCOPE_AGENT); }
__device__ __forceinline__ unsigned xb_add(unsigned* p, unsigned v) { return __hip_atomic_fetch_add(p, v, __ATOMIC_RELAXED, __HIP_MEMORY_SCOPE_AGENT); }
__device__ __forceinline__ unsigned xb_xcc_id() { return (unsigned)__builtin_amdgcn_s_getreg((3 << 11) | 20) & 0xFu; }
#define XB_SPIN(cond, bar) do { unsigned _sp = 0; while (cond) { __builtin_amdgcn_s_sleep(1); \
    if ((++_sp & 255u) == 0u) { if (xb_ld(&(bar)[XB_TMO])) break; if (_sp > XB_SPIN_CAP) { atomicAdd(&(bar)[XB_TMO], 1u); break; } } } } while (0)

struct XcdBarrier {
    unsigned* bar; unsigned x;
    volatile LAS unsigned* st;
};

__device__ __forceinline__ XcdBarrier xcd_barrier_post(unsigned* bar, volatile LAS unsigned* st) {
    XcdBarrier b; b.bar = bar; b.x = xb_xcc_id(); b.st = st;
    if (threadIdx.x == 0) (void)xb_add(&bar[XB_XCNT(b.x)], 1u);
    return b;
}
__device__ __forceinline__ void xcd_barrier_complete(unsigned* bar, unsigned x, unsigned& nloc, unsigned& nx) {
    const unsigned G = gridDim.x * gridDim.y * gridDim.z;
    unsigned sum, cnt, mine, sp = 0u;
    for (;;) {
        sum = 0u; cnt = 0u; mine = 0u;
#pragma unroll
        for (unsigned j = 0; j < 16; ++j) { const unsigned c = xb_ld(&bar[XB_XCNT(j)]); sum += c; cnt += (c > 0u) ? 1u : 0u; mine = (j == x) ? c : mine; }
        if (sum == G) break;
        __builtin_amdgcn_s_sleep(1);
        if ((++sp & 255u) == 0u) { if (xb_ld(&bar[XB_TMO])) break; if (sp > XB_SPIN_CAP) { atomicAdd(&bar[XB_TMO], 1u); break; } }
    }
    nloc = mine > 0u ? mine : 1u; nx = cnt > 0u ? cnt : 1u;
}

__device__ __forceinline__ void xcd_barrier(const XcdBarrier& b) {
    asm volatile("s_waitcnt vmcnt(0)" ::: "memory");
    __syncthreads();
    if (threadIdx.x == 0) {
        unsigned* bar = b.bar;
        __builtin_amdgcn_s_waitcnt(0);
        unsigned nloc = b.st[0], nx = b.st[1];
        if (nloc == 0u) { xcd_barrier_complete(bar, b.x, nloc, nx); b.st[0] = nloc; b.st[1] = nx; }
        const unsigned old = xb_add(&bar[XB_XSUB(b.x)], 1u);
        const unsigned gen = old / nloc;
        if (old + 1u == (gen + 1u) * nloc) {
            __builtin_amdgcn_fence(__ATOMIC_RELEASE, "agent");
            asm volatile("s_waitcnt vmcnt(0)" ::: "memory");
            const unsigned og = xb_add(&bar[XB_TOP], 1u);
            const unsigned tg = og / nx;
            if (og + 1u == (tg + 1u) * nx) xb_add(&bar[XB_TOPGEN], 1u);
            else XB_SPIN(xb_ld(&bar[XB_TOPGEN]) == tg, bar);
            __builtin_amdgcn_fence(__ATOMIC_ACQUIRE, "agent");
            xb_add(&bar[XB_XGEN(b.x)], 1u);
            asm volatile("s_waitcnt vmcnt(0)" ::: "memory");
        } else {
            XB_SPIN(xb_ld(&bar[XB_XGEN(b.x)]) == gen, bar);
            __builtin_amdgcn_fence(__ATOMIC_ACQUIRE, "agent");
            asm volatile("s_waitcnt vmcnt(0)" ::: "memory");
        }
    }
    __syncthreads();
}

__device__ __forceinline__ unsigned f2bf(float f) { unsigned u = __builtin_bit_cast(unsigned, f); return (u + 0x7fffu + ((u >> 16) & 1u)) >> 16; }
__device__ __forceinline__ unsigned pk2(float lo, float hi) { return f2bf(lo) | (f2bf(hi) << 16); }
__device__ __forceinline__ float bf_lo(unsigned w) { return __builtin_bit_cast(float, w << 16); }
__device__ __forceinline__ float bf_hi(unsigned w) { return __builtin_bit_cast(float, w & 0xffff0000u); }
__device__ __forceinline__ float wave_sum(float v) {
#pragma unroll
    for (int o = 1; o < 64; o <<= 1) v += __shfl_xor(v, o);
    return v;
}
__constant__ double ROPE_REV[32] = {
0.15915494309189535,
0.11934937021124886,
0.08949940160889101,
0.06711508300522726,
0.050329212104487035,
0.03774158471741977,
0.0283021958306234,
0.02122365276477766,
0.015915494309189534,
0.011934937021124886,
0.008949940160889102,
0.006711508300522725,
0.005032921210448704,
0.003774158471741977,
0.00283021958306234,
0.0021223652764777662,
0.0015915494309189536,
0.0011934937021124885,
0.0008949940160889102,
0.0006711508300522726,
0.0005032921210448703,
0.00037741584717419774,
0.00028302195830623395,
0.0002122365276477766,
0.00015915494309189535,
0.00011934937021124886,
8.949940160889102e-05,
6.711508300522725e-05,
5.0329212104487035e-05,
3.774158471741978e-05,
2.8302195830623396e-05,
2.122365276477766e-05
};
__device__ __forceinline__ void p0_transpose_item(const float* W, int K, int N, bf16* WT, int mode, const float* gain, LAS float* scr, int item, int lane) {
    const int nblk = N / 32, kb = item / nblk, nb = item % nblk, k0 = 64 * kb, n0 = 32 * nb;
    int dst;
    if (mode == 0) dst = n0;
    else if (mode == 1) { const int pn = n0 >> 8, r = n0 & 255; dst = pn * 256 + ((r >> 5) & 1) * 128 + (r >> 6) * 32; }
    else { const int pn = n0 >> 7, q0 = n0 & 127; dst = pn * 256 + (mode == 3 ? 128 : 0) + q0; }
    float wv[32];
#pragma unroll
    for (int i = 0; i < 32; ++i) { const int kk = 2 * i + (lane >> 5); wv[i] = __builtin_nontemporal_load(W + (size_t)(k0 + kk) * N + n0 + (lane & 31)); }
#pragma unroll
    for (int i = 0; i < 32; ++i) { const int kk = 2 * i + (lane >> 5); float w = wv[i]; if (gain) w *= gain[k0 + kk]; scr[kk * 33 + (lane & 31)] = w; }
    LDS_WAIT(); asm volatile("" ::: "memory");
    const int c = lane & 7;
#pragma unroll
    for (int j = 0; j < 4; ++j) { const int n = (lane >> 3) + 8 * j; const LAS float* s = scr + (8 * c) * 33 + n;
        v4u o; o.x = pk2(s[0 * 33], s[1 * 33]); o.y = pk2(s[2 * 33], s[3 * 33]); o.z = pk2(s[4 * 33], s[5 * 33]); o.w = pk2(s[6 * 33], s[7 * 33]);
        *(GAS v4u*)(WT + (size_t)(dst + n) * K + k0 + 8 * c) = o; }
    LDS_WAIT(); asm volatile("" ::: "memory");
}
#ifndef REP_G1
#define REP_G1 1
#endif
#ifndef REP_X
#define REP_X 1
#endif
#ifndef REP_Y
#define REP_Y 1
#endif
struct Args { const float* in[17]; float* out; unsigned char* ws; };
enum { I_X = 0, I_ATTN_NORM, I_W_IN, I_MQN, I_MKN, I_DQN, I_DKN, I_LQ1, I_LK1, I_LQ2, I_LK2, I_SUBLN, I_W_OUT, I_FFN_NORM, I_W_GATE, I_W_UP, I_W_DOWN };

__global__ void __launch_bounds__(NWAVES * 64, 2) hymba_fwd(Args args) {
    extern __shared__ __attribute__((aligned(16))) unsigned char lds[];
    cg::grid_group grid = cg::this_grid();
    volatile __attribute__((address_space(3))) unsigned* const xb_st = (volatile __attribute__((address_space(3))) unsigned*)((__attribute__((address_space(3))) unsigned char*)lds + 131072 + 64);
    if (threadIdx.x < 2) xb_st[threadIdx.x] = 0u;
    __syncthreads();
    const XcdBarrier xbar = xcd_barrier_post((unsigned*)(args.ws + WS_BAR), xb_st);
    LAS unsigned char* const ldsl = (LAS unsigned char*)lds;
    const int tid = threadIdx.x, lane = tid & 63, wave = __builtin_amdgcn_readfirstlane(tid >> 6);
    const int G = gridDim.x; const int bx = blockIdx.x;
    const int vcu = (G % 8 == 0) ? (bx % 8) * (G / 8) + bx / 8 : bx;
    unsigned char* const ws = args.ws;
    bf16* const Win_t = (bf16*)(ws + WS_WIN); bf16* const Wout_t = (bf16*)(ws + WS_WOUT); bf16* const Wgu_t = (bf16*)(ws + WS_WGU); bf16* const Wdn_t = (bf16*)(ws + WS_WDN);
    float* const rcos = (float*)(ws + WS_ROPE); float* const rsin = rcos + 8192 * 32;
    float* const gtab = (float*)(ws + WS_GTAB); float* const kmean = (float*)(ws + WS_KMEAN); float* const SS = (float*)(ws + WS_SS);
    bf16* const XN = (bf16*)(ws + WS_XN); bf16* const QKV = (bf16*)(ws + WS_QKV); bf16* const HB = (bf16*)(ws + WS_QKV);
    bf16* const OST = (bf16*)(ws + WS_OST); bf16* const MIX = (bf16*)(ws + WS_MIX);
    unsigned short* const GL = (unsigned short*)(ws + WS_GL); unsigned* const GC = (unsigned*)(ws + WS_GC); float* const LP = (float*)(ws + WS_LP); bf16* const OP = (bf16*)(ws + WS_OP);
    const float* const x = args.in[I_X]; float* const out = args.out;

    {
        LAS float* scr = (LAS float*)(ldsl + wave * 16384);
        const int gw = vcu * NWAVES + wave, NGW = G * NWAVES;
        constexpr int I_IN = (DM / 64) * (NPROJ / 32), I_OUT = (DM / 64) * (DM / 32), I_G = (DM / 64) * (FFN / 32), I_D = (FFN / 64) * (DM / 32);
        constexpr int NITEMS = I_IN + I_OUT + 2 * I_G + I_D;
        for (int it = gw; it < NITEMS; it += NGW) {
            int r = it;
            if (r < I_IN) { p0_transpose_item(args.in[I_W_IN], DM, NPROJ, Win_t, 1, nullptr, scr, r, lane); continue; } r -= I_IN;
            if (r < I_OUT) { p0_transpose_item(args.in[I_W_OUT], DM, DM, Wout_t, 0, nullptr, scr, r, lane); continue; } r -= I_OUT;
            if (r < I_G) { p0_transpose_item(args.in[I_W_GATE], DM, FFN, Wgu_t, 2, args.in[I_FFN_NORM], scr, r, lane); continue; } r -= I_G;
            if (r < I_G) { p0_transpose_item(args.in[I_W_UP], DM, FFN, Wgu_t, 3, args.in[I_FFN_NORM], scr, r, lane); continue; } r -= I_G;
            p0_transpose_item(args.in[I_W_DOWN], FFN, DM, Wdn_t, 0, nullptr, scr, r, lane);
        }
        const GAS f32x4* gp = (const GAS f32x4*)args.in[I_ATTN_NORM] + lane;
        f32x4 gn[4];
#pragma unroll
        for (int j = 0; j < 4; ++j) gn[j] = gp[64 * j];
        for (int m0 = gw; m0 < M; m0 += 2 * NGW) {
            const int m1 = (m0 + NGW < M) ? m0 + NGW : m0;
            const GAS f32x4* xr0 = (const GAS f32x4*)(x + (size_t)m0 * DM) + lane; const GAS f32x4* xr1 = (const GAS f32x4*)(x + (size_t)m1 * DM) + lane;
            f32x4 v0[4], v1[4]; float s0 = 0.f, s1 = 0.f;
#pragma unroll
            for (int j = 0; j < 4; ++j) { v0[j] = __builtin_nontemporal_load(xr0 + 64 * j); v1[j] = __builtin_nontemporal_load(xr1 + 64 * j); }
#pragma unroll
            for (int j = 0; j < 4; ++j) { s0 += (v0[j].x * v0[j].x + v0[j].y * v0[j].y) + (v0[j].z * v0[j].z + v0[j].w * v0[j].w); s1 += (v1[j].x * v1[j].x + v1[j].y * v1[j].y) + (v1[j].z * v1[j].z + v1[j].w * v1[j].w); }
#pragma unroll
            for (int o = 1; o < 64; o <<= 1) { s0 += __shfl_xor(s0, o); s1 += __shfl_xor(s1, o); }
            const float r0 = 1.0f / sqrtf(s0 * (1.f / DM) + 1e-6f), r1 = 1.0f / sqrtf(s1 * (1.f / DM) + 1e-6f);
            GAS unsigned long long* o0 = (GAS unsigned long long*)(XN + (size_t)m0 * DM) + lane; GAS unsigned long long* o1 = (GAS unsigned long long*)(XN + (size_t)m1 * DM) + lane;
#pragma unroll
            for (int j = 0; j < 4; ++j) { const f32x4 w0 = v0[j] * r0 * gn[j], w1 = v1[j] * r1 * gn[j];
                o0[64 * j] = (unsigned long long)pk2(w0.x, w0.y) | ((unsigned long long)pk2(w0.z, w0.w) << 32); o1[64 * j] = (unsigned long long)pk2(w1.x, w1.y) | ((unsigned long long)pk2(w1.z, w1.w) << 32); }
        }
        if (bx == 0) {
            if (tid < 64) gtab[tid] = args.in[I_MQN][tid];
            else if (tid < 128) gtab[tid] = args.in[I_MKN][tid - 64];
            else if (tid < 192) gtab[tid + 64] = args.in[I_DQN][tid - 128];
            else if (tid < 256) gtab[tid + 64] = args.in[I_DKN][tid - 192];
        }
        for (int e = bx * (NWAVES * 64) + tid; e < 8192 * 32; e += G * NWAVES * 64) {
            const int pos = e >> 5, i = e & 31;
            const double rev = (double)pos * ROPE_REV[i]; const float fr = (float)(rev - __builtin_rint(rev));
            rcos[e] = __builtin_amdgcn_cosf(fr); rsin[e] = __builtin_amdgcn_sinf(fr);
        }
    }
    if (gridDim.y == 0x7fffu) grid.sync();
    xcd_barrier(xbar);
    {
        pg8::Gemm g{XN, Win_t, M, NPROJ, DM}; pg8::StaticOrder S; S.init(M, NPROJ, G, bx);
        pg8::EpiQKV E{QKV, gtab, rcos, rsin, attn_body::C2, kmean};
        pg8::gemm_phase<pg8::EpiQKV, pg8::StaticOrder, PG8_ALIGN, PG8_SP2>(ldsl, g, S, E);
    }
    xcd_barrier(xbar);
    {
        const int r32 = lane & 31, hi = lane >> 5;
        for (int rep_ = 0; rep_ < REP_G1; ++rep_) {
#define G1_DECODE(U0, BH, QB) const int BH = (U0) >> 5, QB = (((U0) & 31) + 8 * ((U0) >> 8)) & 31
#define G1_LOADS(U0) do { if ((U0) < BATCH * 8 * 32) { G1_DECODE(U0, bh_, qb_); const float* kp_ = kmean + ((size_t)(bh_ * 32 + (tid >> 4)) * 2) * 64 + (tid & 15) * 4; pka = *(const GAS f32x4*)kp_; pkb = *(const GAS f32x4*)(kp_ + 64); \
            const bf16* qp_ = QKV + ((size_t)((bh_ >> 3) * 48 + (bh_ & 7)) * SEQ + qb_ * 256 + wave * 32 + r32) * 64 + hi * 8; _Pragma("unroll") for (int c_ = 0; c_ < 4; ++c_) pqw[c_] = *(const GAS v4u*)(qp_ + c_ * 16); } } while (0)
        f32x4 pka, pkb; v4u pqw[4];
        G1_LOADS(vcu);
        int par = 0, pbh = -1, pqb = 0;
        for (int u0 = vcu; u0 < BATCH * 8 * 32; u0 += G, par ^= 1) {
            G1_DECODE(u0, bh, qb); const int u = bh * 32 + qb;
            LAS unsigned char* kmh = ldsl + par * 16384; LAS unsigned char* kml = kmh + 8192;
            LAS unsigned* cnt = (LAS unsigned*)(ldsl + 32768 + par * 128); LAS unsigned* pcnt = (LAS unsigned*)(ldsl + 32768 + (par ^ 1) * 128);
            if (tid < 32) cnt[tid] = 0u;
            { const f32x4 m4 = (pka + pkb) * (1.0f / 256.0f);
              const int n_ = tid >> 4, d_ = (tid & 15) * 4; const unsigned off = (unsigned)((d_ >> 3) * 1024 + n_ * 16 + (d_ & 7) * 2);
              unsigned hw[4]; float lf[4];
#pragma unroll
              for (int e = 0; e < 4; ++e) { hw[e] = f2bf(m4[e]); lf[e] = m4[e] - __builtin_bit_cast(float, hw[e] << 16); }
              *(LAS unsigned long long*)(kmh + off) = (unsigned long long)(hw[0] | (hw[1] << 16)) | ((unsigned long long)(hw[2] | (hw[3] << 16)) << 32);
              *(LAS unsigned long long*)(kml + off) = (unsigned long long)pk2(lf[0], lf[1]) | ((unsigned long long)pk2(lf[2], lf[3]) << 32); }
            attn_body::bf16x8 qf[4];
#pragma unroll
            for (int c = 0; c < 4; ++c) qf[c] = __builtin_bit_cast(attn_body::bf16x8, pqw[c]);
            G1_LOADS(u0 + G);
            __syncthreads();
            if (pbh >= 0 && tid < 32) GC[(pbh * 32 + tid) * 32 + pqb] = pcnt[tid];
            pbh = bh; pqb = qb;
            attn_body::f32x16 gt = {};
#pragma unroll
            for (int d0 = 0; d0 < 4; ++d0) {
                const attn_body::bf16x8 kh_ = *(const LAS attn_body::bf16x8*)(kmh + hi * 1024 + r32 * 16 + d0 * 2048), kl_ = *(const LAS attn_body::bf16x8*)(kml + hi * 1024 + r32 * 16 + d0 * 2048);
                gt = __builtin_amdgcn_mfma_f32_32x32x16_bf16(kh_, qf[d0], gt, 0, 0, 0); gt = __builtin_amdgcn_mfma_f32_32x32x16_bf16(kl_, qf[d0], gt, 0, 0, 0); }
            float v1 = -INFINITY, v2 = -INFINITY, v3 = -INFINITY; int i1 = 0, i2 = 0, i3 = 0;
#pragma unroll
            for (int r = 0; r < 16; ++r) { const int n = (r & 3) + 8 * (r >> 2) + 4 * hi; const float p = n < qb ? gt[r] : -INFINITY;
                const bool g1 = p > v1, g2 = p > v2, g3 = p > v3;
                v3 = g2 ? v2 : (g3 ? p : v3); i3 = g2 ? i2 : (g3 ? n : i3);
                v2 = g1 ? v1 : (g2 ? p : v2); i2 = g1 ? i1 : (g2 ? n : i2);
                v1 = g1 ? p : v1; i1 = g1 ? n : i1; }
            { const float w1 = __shfl_xor(v1, 32), w2 = __shfl_xor(v2, 32), w3 = __shfl_xor(v3, 32); const int j1 = __shfl_xor(i1, 32), j2 = __shfl_xor(i2, 32), j3 = __shfl_xor(i3, 32);
#define G1_INS(P, N) do { const float p_ = (P); const int n_ = (N); const bool g1 = p_ > v1 || (p_ == v1 && n_ < i1), g2 = p_ > v2 || (p_ == v2 && n_ < i2), g3 = p_ > v3 || (p_ == v3 && n_ < i3); \
                v3 = g2 ? v2 : (g3 ? p_ : v3); i3 = g2 ? i2 : (g3 ? n_ : i3); v2 = g1 ? v1 : (g2 ? p_ : v2); i2 = g1 ? i1 : (g2 ? n_ : i2); v1 = g1 ? p_ : v1; i1 = g1 ? n_ : i1; } while (0)
              G1_INS(w1, j1); G1_INS(w2, j2); G1_INS(w3, j3);
#undef G1_INS
            }
            if (hi == 0) {
                const unsigned row = (unsigned)(wave * 32 + r32);
                if (qb >= 1) { const unsigned pos = __hip_atomic_fetch_add(cnt + i1, 1u, __ATOMIC_RELAXED, __HIP_MEMORY_SCOPE_WORKGROUP); GL[((size_t)u * 32 + i1) * 256 + pos] = (unsigned short)(row | (0u << 8)); }
                if (qb >= 2) { const unsigned pos = __hip_atomic_fetch_add(cnt + i2, 1u, __ATOMIC_RELAXED, __HIP_MEMORY_SCOPE_WORKGROUP); GL[((size_t)u * 32 + i2) * 256 + pos] = (unsigned short)(row | (1u << 8)); }
                if (qb >= 3) { const unsigned pos = __hip_atomic_fetch_add(cnt + i3, 1u, __ATOMIC_RELAXED, __HIP_MEMORY_SCOPE_WORKGROUP); GL[((size_t)u * 32 + i3) * 256 + pos] = (unsigned short)(row | (2u << 8)); }
            }
        }
        __syncthreads();
        if (pbh >= 0 && tid < 32) GC[(pbh * 32 + tid) * 32 + pqb] = ((LAS unsigned*)(ldsl + 32768 + (par ^ 1) * 128))[tid];
        __syncthreads();
        }
#undef G1_LOADS
#undef G1_DECODE
    }
    xcd_barrier(xbar);
    float lam;
    { float d1 = args.in[I_LQ1][lane] * args.in[I_LK1][lane], d2 = args.in[I_LQ2][lane] * args.in[I_LK2][lane];
      d1 = wave_sum(d1); d2 = wave_sum(d2);
      lam = __builtin_amdgcn_exp2f(d1 * 1.4426950408889634f) - __builtin_amdgcn_exp2f(d2 * 1.4426950408889634f) + 0.2f; }
#pragma unroll 1
    for (int ph = 0; ph < 2; ++ph) {
        const int r32 = lane & 31;
        LAS unsigned* gpre = (LAS unsigned*)(ldsl + 110592);
        LAS unsigned* nlist = (LAS unsigned*)(ldsl + 114688);
        LAS unsigned* pq = (LAS unsigned*)(ldsl + 118784);
        if (ph == 0) {
            for (int L = tid; L < 1024; L += NWAVES * 64) {
                unsigned n = 0;
                if (L < 992) { const int bh = L / 31, ix = L % 31, jj = (ix & 1) ? 30 - (ix >> 1) : (ix >> 1);     const v4u* cp = (const v4u*)(GC + (size_t)(bh * 32 + jj) * 32);
#pragma unroll
                    for (int c = 0; c < 8; ++c) { const v4u w = cp[c]; n += (w.x + w.y) + (w.z + w.w); }
                    nlist[L] = n; }
                gpre[L] = (n + 31u) >> 5;
            }
            __syncthreads();
            if (wave == 0) {
                unsigned c[16], sum = 0;
#pragma unroll
                for (int k = 0; k < 16; ++k) { c[k] = gpre[lane * 16 + k]; sum += c[k]; }
                unsigned incl = sum;
#pragma unroll
                for (int o = 1; o < 64; o <<= 1) { const unsigned t = __shfl_up(incl, o); if (lane >= o) incl += t; }
                unsigned run = incl - sum;
#pragma unroll
                for (int k = 0; k < 16; ++k) { gpre[lane * 16 + k] = run; run += c[k]; }
            }
            __syncthreads();
        }
        for (int v = vcu; v < 256; v += G) {
#pragma unroll 1
            for (int which = 0; which < 2; ++which) {
                const int bh = v >> 4, s = v & 15, b = bh >> 2, dh = bh & 3, mm = ph;
                const int qb = which ? 31 - s : s;
                const bf16* base = QKV + (size_t)b * 48 * SEQ * 64;
                attn_body::attn_unit_dv(qb, (const attn_body::bf16*)(base + (size_t)(24 + 2 * dh + mm) * SEQ * 64), (const attn_body::bf16*)(base + (size_t)(32 + 2 * dh + mm) * SEQ * 64),
                                        (const attn_body::bf16*)(base + (size_t)(40 + 2 * dh) * SEQ * 64), (attn_body::bf16*)(OST + (size_t)b * SEQ * DM + (2 * dh + mm) * 128), (char*)lds);
            }
            if (ph == 0) for (int rep_ = 0; rep_ < REP_X; ++rep_) {
                const unsigned T = gpre[992];
                unsigned lo = (unsigned)(((unsigned long long)T * (unsigned)v) >> 8), hiT = (unsigned)(((unsigned long long)T * (unsigned)(v + 1)) >> 8);
                int L = 0; { int a = 0, bnd = 992; while (bnd - a > 1) { const int mid = (a + bnd) >> 1; if (gpre[mid] <= lo) a = mid; else bnd = mid; } L = a; }
                const int L0 = L; LAS unsigned* const pqt = (LAS unsigned*)(ldsl + 118784 + 256);
                {
                    for (int li = wave; li < 16; li += NWAVES) { const int Lx = L0 + li;
                        if (Lx < 992) { const int bhx = Lx / 31, ixx = Lx % 31, jjx = (ixx & 1) ? 30 - (ixx >> 1) : (ixx >> 1);
                            const unsigned cq = (lane < 32) ? GC[(size_t)(bhx * 32 + jjx) * 32 + lane] : 0u; unsigned incl = cq;
#pragma unroll
                            for (int o = 1; o < 32; o <<= 1) { const unsigned t = __shfl_up(incl, o); if (lane >= o) incl += t; }
                            if (lane < 32) pqt[li * 33 + lane + 1] = incl; if (lane == 0) pqt[li * 33] = 0u; } }
                    __syncthreads();
                }
#pragma unroll 1
                while (lo < hiT) {
                    const unsigned g0 = gpre[L], g1 = gpre[L + 1];
                    if (g1 <= lo) { ++L; continue; }
                    const unsigned segE = (hiT < g1 ? hiT : g1);
                    const int bh = L / 31, ix = L % 31, jj = (ix & 1) ? 30 - (ix >> 1) : (ix >> 1); const unsigned n = nlist[L];
                    const bool pre = (L - L0) < 16; LAS unsigned* const pqs = pre ? pqt + (L - L0) * 33 : pq;
                    if (!pre && tid < 64) {
                        const unsigned cq = (lane < 32) ? GC[(size_t)(bh * 32 + jj) * 32 + lane] : 0u; unsigned incl = cq;
#pragma unroll
                        for (int o = 1; o < 32; o <<= 1) { const unsigned t = __shfl_up(incl, o); if (lane >= o) incl += t; }
                        if (lane < 32) pq[lane + 1] = incl; if (lane == 0) pq[0] = 0u;
                    }
                    const bf16* hb = QKV + (size_t)((bh >> 3) * 48 + (bh & 7)) * SEQ * 64;
                    if (!pre) __syncthreads();
                    const unsigned wend = segE - g0;
                    int lane_ = tid & 63; asm volatile("" : "+v"(lane_)); const int lane = lane_, r32 = lane & 31;
#define MB_RESOLVE(W, VALID, QBQ, ENT) do { const unsigned p_ = (W) * 32 + r32; VALID = ((W) < wend) && (p_ < n); int a_ = 0, bnd_ = 32; while (bnd_ - a_ > 1) { const int mid_ = (a_ + bnd_) >> 1; if (pqs[mid_] <= p_) a_ = mid_; else bnd_ = mid_; } QBQ = a_; \
                        ENT = 0; if (VALID) ENT = GL[((size_t)(bh * 32 + a_) * 32 + jj) * 256 + (p_ - pqs[a_])]; } while (0)
                    unsigned w = (lo - g0) + wave;
                    bool val0, val1, val2; int qq0, qq1, qq2; unsigned en0, en1, en2;
                    MB_RESOLVE(w, val0, qq0, en0); MB_RESOLVE(w + NWAVES, val1, qq1, en1);
                    attn_body::moba_load_block((const attn_body::bf16*)(hb + (size_t)8 * SEQ * 64 + (size_t)jj * 256 * 64), (const attn_body::bf16*)(hb + (size_t)16 * SEQ * 64 + (size_t)jj * 256 * 64), (char*)lds);
                    attn_body::MobaQ qa = attn_body::moba_qload((const attn_body::bf16*)hb, val0 ? qq0 * 256 + (int)(en0 & 255u) : 0);
#pragma unroll 1
                    for (; w < wend; w += NWAVES) {
                        MB_RESOLVE(w + 2 * NWAVES, val2, qq2, en2);
                        const attn_body::MobaQ qn = attn_body::moba_qload((const attn_body::bf16*)hb, val1 ? qq1 * 256 + (int)(en1 & 255u) : 0);
                        const bool valid = val0; const int qrow = val0 ? qq0 * 256 + (int)(en0 & 255u) : 0; const int rank = (int)(en0 >> 8);
                        attn_body::moba_task<false>(qa, 0, (char*)lds);
                        const bf16* stg = (const bf16*)((char*)lds + attn_body::MB_OST) + wave * 2048; const float* wsf = (const float*)((char*)lds + attn_body::MB_WS) + wave * 64;
                        if (valid && lane < 32) LP[(size_t)rank * (M * 8) + (size_t)bh * SEQ + qrow] = wsf[32 + r32];
#pragma unroll
                        for (int i = 0; i < 4; ++i) { const int row = i * 8 + (lane >> 3), ch = lane & 7; const v4u val = *(const v4u*)(stg + row * 64 + ch * 8);
                            const int pd = __shfl(valid ? ((rank << 20) | qrow) : -1, row);
                            if (pd >= 0) __builtin_nontemporal_store(val, (GAS v4u*)(OP + ((size_t)(pd >> 20) * (M * 8) + (size_t)bh * SEQ + (pd & 0xfffff)) * 64 + ch * 8)); }
                        asm volatile("s_waitcnt lgkmcnt(0)" ::: "memory");
                        qa = qn; val0 = val1; qq0 = qq1; en0 = en1; val1 = val2; qq1 = qq2; en1 = en2;
                    }
#undef MB_RESOLVE
                    __syncthreads();
                    lo = segE; ++L;
                }
            } else for (int rep_ = 0; rep_ < REP_Y; ++rep_) {
#pragma unroll 1
                for (int i = 0; i < 4; ++i) {
                    int lane_ = tid & 63; asm volatile("" : "+v"(lane_)); const int lane = lane_, r32 = lane & 31;
                    const int bh = v >> 3, s = v & 7; const int qb = (i == 0) ? s : (i == 1) ? 15 - s : (i == 2) ? 16 + s : 31 - s;
                    const int grp = wave < 4 ? wave : 11 - wave;
                    const bf16* hb = QKV + (size_t)((bh >> 3) * 48 + (bh & 7)) * SEQ * 64;
                    const int qrow = qb * 256 + grp * 32 + r32;
                    const int nsel = qb < 3 ? qb : 3;
                    const attn_body::MobaQ qa = attn_body::moba_qload((const attn_body::bf16*)hb, qrow);
                    v4u pk[4][3]; float lk[4][3];
#pragma unroll
                    for (int it = 0; it < 4; ++it) { const size_t hr = (size_t)bh * SEQ + qb * 256 + grp * 32 + it * 8 + (lane >> 3);
#pragma unroll
                        for (int k = 0; k < 3; ++k) { pk[it][k] = (v4u){0u, 0u, 0u, 0u}; lk[it][k] = 0.f;
                            if (k < nsel) { lk[it][k] = LP[(size_t)k * (M * 8) + hr]; pk[it][k] = __builtin_nontemporal_load((const GAS v4u*)(OP + ((size_t)k * (M * 8) + hr) * 64 + (lane & 7) * 8)); } } }
                    attn_body::moba_load_block((const attn_body::bf16*)(hb + (size_t)8 * SEQ * 64 + (size_t)qb * 256 * 64), (const attn_body::bf16*)(hb + (size_t)16 * SEQ * 64 + (size_t)qb * 256 * 64), (char*)lds);
                    attn_body::moba_task<true>(qa, grp * 32 + r32, (char*)lds);
                    const bf16* stg = (const bf16*)((char*)lds + attn_body::MB_OST) + wave * 2048; const float* wsf = (const float*)((char*)lds + attn_body::MB_WS) + wave * 64;
#pragma unroll
                    for (int it = 0; it < 4; ++it) { const int row = it * 8 + (lane >> 3), ch = lane & 7; const v4u val = *(const v4u*)(stg + row * 64 + ch * 8);
                        float lt = wsf[32 + row]; float a[8];
                        a[0] = bf_lo(val.x) * lt; a[1] = bf_hi(val.x) * lt; a[2] = bf_lo(val.y) * lt; a[3] = bf_hi(val.y) * lt; a[4] = bf_lo(val.z) * lt; a[5] = bf_hi(val.z) * lt; a[6] = bf_lo(val.w) * lt; a[7] = bf_hi(val.w) * lt;
#pragma unroll
                        for (int k = 0; k < 3; ++k) { const float l2 = lk[it][k]; const v4u p2 = pk[it][k];
                            a[0] += bf_lo(p2.x) * l2; a[1] += bf_hi(p2.x) * l2; a[2] += bf_lo(p2.y) * l2; a[3] += bf_hi(p2.y) * l2; a[4] += bf_lo(p2.z) * l2; a[5] += bf_hi(p2.z) * l2; a[6] += bf_lo(p2.w) * l2; a[7] += bf_hi(p2.w) * l2; lt += l2; }
                        const float rl = 1.0f / lt;
                        v4u o; o.x = pk2(a[0] * rl, a[1] * rl); o.y = pk2(a[2] * rl, a[3] * rl); o.z = pk2(a[4] * rl, a[5] * rl); o.w = pk2(a[6] * rl, a[7] * rl);
                        *(GAS v4u*)(MIX + ((size_t)(bh >> 3) * SEQ + qb * 256 + grp * 32 + row) * DM + (bh & 7) * 64 + ch * 8) = o; }
                    asm volatile("s_waitcnt lgkmcnt(0)" ::: "memory");
                    __syncthreads();
                }
            }
            if (ph == 1) {
                asm volatile("s_waitcnt vmcnt(0)" ::: "memory");
                int lane_ = tid & 63; asm volatile("" : "+v"(lane_)); const int lane = lane_;
                const int bh = v >> 4, b = bh >> 2, dh = bh & 3;
                const int dch = lane & 15;
                const f32x4 sg0 = *(const GAS f32x4*)(args.in[I_SUBLN] + dch * 8), sg1 = *(const GAS f32x4*)(args.in[I_SUBLN] + dch * 8 + 4);
#pragma unroll 1
                for (int w2 = 0; w2 < 2; ++w2) {
                    const int qb = w2 ? 31 - (v & 15) : (v & 15);
#pragma unroll 8
                    for (int it = 0; it < 8; ++it) {
                        const size_t row = (size_t)b * SEQ + qb * 256 + wave * 32 + it * 4 + (lane >> 4);
                        const v4u w0 = __builtin_nontemporal_load((const GAS v4u*)(OST + row * DM + (2 * dh) * 128 + dch * 8));
                        const v4u w1 = __builtin_nontemporal_load((const GAS v4u*)(OST + row * DM + (2 * dh + 1) * 128 + dch * 8));
                        float a[8];
                        a[0] = bf_lo(w0.x) - lam * bf_lo(w1.x); a[1] = bf_hi(w0.x) - lam * bf_hi(w1.x); a[2] = bf_lo(w0.y) - lam * bf_lo(w1.y); a[3] = bf_hi(w0.y) - lam * bf_hi(w1.y);
                        a[4] = bf_lo(w0.z) - lam * bf_lo(w1.z); a[5] = bf_hi(w0.z) - lam * bf_hi(w1.z); a[6] = bf_lo(w0.w) - lam * bf_lo(w1.w); a[7] = bf_hi(w0.w) - lam * bf_hi(w1.w);
                        float ss = 0.f;
#pragma unroll
                        for (int jx = 0; jx < 8; ++jx) ss += a[jx] * a[jx];
                        ss += __shfl_xor(ss, 1); ss += __shfl_xor(ss, 2); ss += __shfl_xor(ss, 4); ss += __shfl_xor(ss, 8);
                        const float rs = __builtin_amdgcn_rsqf(ss * (1.0f / 128.0f) + 1e-6f) * 0.8f;
                        v4u o; o.x = pk2(a[0] * rs * sg0[0], a[1] * rs * sg0[1]); o.y = pk2(a[2] * rs * sg0[2], a[3] * rs * sg0[3]);
                        o.z = pk2(a[4] * rs * sg1[0], a[5] * rs * sg1[1]); o.w = pk2(a[6] * rs * sg1[2], a[7] * rs * sg1[3]);
                        *(GAS v4u*)(MIX + row * DM + 512 + dh * 128 + dch * 8) = o;
                    }
                }
            }
        }
        xcd_barrier(xbar);
    }
    {
        pg8::Gemm g{MIX, Wout_t, M, DM, DM}; pg8::StaticOrder S; S.init(M, DM, G, bx);
        pg8::EpiOut E{x, XN, SS};
        pg8::gemm_phase<pg8::EpiOut, pg8::StaticOrder, PG8_ALIGN, PG8_SP2>(ldsl, g, S, E);
    }
    xcd_barrier(xbar);
    {
        pg8::Gemm g{XN, Wgu_t, M, NGU, DM}; pg8::StaticOrder S; S.init(M, NGU, G, bx);
        pg8::EpiSwiGLU E{SS, HB};
        pg8::gemm_phase<pg8::EpiSwiGLU, pg8::StaticOrder, PG8_ALIGN, PG8_SP2>(ldsl, g, S, E);
    }
    xcd_barrier(xbar);
    {
        pg8::Gemm g{HB, Wdn_t, M, DM, FFN}; pg8::StaticOrder S; S.init(M, DM, G, bx);
        pg8::EpiDown E{XN, out};
        pg8::gemm_phase<pg8::EpiDown, pg8::StaticOrder, PG8_ALIGN, PG8_SP2>(ldsl, g, S, E);
    }
}

extern "C" void kernel_launch(void* const* d_in, const int* in_sizes, int n_in, void* d_out, int out_size, void* d_ws, size_t ws_size, hipStream_t stream) {
    static int grid = 0;
    if (grid == 0) {
        if (n_in != 17 || out_size != M * DM || ws_size < WS_END) { fprintf(stderr, "kernel_launch: unexpected problem (n_in %d out %d ws %zu)\n", n_in, out_size, ws_size); grid = -1; return; }
        int dev = 0, cus = 0, per_cu = 0;
        hipGetDevice(&dev); hipDeviceGetAttribute(&cus, hipDeviceAttributeMultiprocessorCount, dev);
        if (hipFuncSetAttribute((const void*)hymba_fwd, hipFuncAttributeMaxDynamicSharedMemorySize, LDS_BYTES) != hipSuccess) { fprintf(stderr, "kernel_launch: hipFuncSetAttribute failed\n"); grid = -1; return; }
        if (hipOccupancyMaxActiveBlocksPerMultiprocessor(&per_cu, (const void*)hymba_fwd, NWAVES * 64, LDS_BYTES) != hipSuccess || per_cu < 1) { fprintf(stderr, "kernel_launch: occupancy query says %d\n", per_cu); per_cu = 1; }
        (void)hipGetLastError();
        grid = cus;
    }
    if (grid < 0) return;
    Args a{};
    for (int i = 0; i < 17; ++i) a.in[i] = (const float*)d_in[i];
    a.out = (float*)d_out; a.ws = (unsigned char*)d_ws;
    if (hipMemsetAsync((char*)d_ws + WS_BAR, 0, 16384, stream) != hipSuccess) { fprintf(stderr, "kernel_launch: hipMemsetAsync failed\n"); return; }
    void* kargs[] = {&a};
    hipError_t e = hipLaunchCooperativeKernel((const void*)hymba_fwd, dim3(grid), dim3(NWAVES * 64), kargs, LDS_BYTES, stream);
    if (e != hipSuccess) fprintf(stderr, "kernel_launch: cooperative launch failed: %s (grid %d)\n", hipGetErrorString(e), grid);
}
```

```cpp
#include <hip/hip_runtime.h>
#include <cstdio>
#include <cstdint>
namespace pg8 {
#define PG8_LAS __attribute__((address_space(3)))
typedef unsigned short bf16_t;
typedef short bf16x8 __attribute__((ext_vector_type(8)));
typedef float f32x4 __attribute__((ext_vector_type(4)));
typedef unsigned u32x4 __attribute__((ext_vector_type(4)));
constexpr int BM = 256, BK = 64, HALF = 128, HTB = HALF * BK * 2  , STAGE_BYTES = 8 * HTB, NXCD = 8, WGM = 8;

__host__ __device__ __forceinline__ int lds_byte(int r, int c) { const int st = (r >> 4) * 2 + (c >> 5), rr = r & 15, cc = c & 31, ob = rr * 64 + cc * 2; return st * 1024 + (ob ^ (((ob >> 9) & 1) << 5)); }
__host__ __device__ __forceinline__ void stage_rc(int b, int& R, int& C) { const int st = b / 1024, sb = b % 1024, swz = sb ^ (((sb >> 9) & 1) << 5); R = (st >> 1) * 16 + swz / 64; C = (st & 1) * 32 + (swz % 64) / 2; }
__host__ __device__ __forceinline__ int perm32(int rho) { const int n = rho >> 4, i = rho & 15; return 8 * (i >> 2) + 4 * n + (i & 3); }

struct Unit { int pm, pn; };
struct Gemm { const bf16_t* A; const bf16_t* Bt; int M, N, K; };

struct StaticOrder {
    int nM, nN, nwg, G, c;
    __host__ __device__ void init(int M, int N, int G_, int c_) { nM = M / BM; nN = N / BM; nwg = nM * nN; G = G_; c = c_; }
    __host__ __device__ bool next(int i, Unit& u) const {
        const long L = (long)i * G + c; if (L >= nwg) return false;
        int wgid = (int)L; { const int q = nwg / NXCD, r = nwg % NXCD, xcd = wgid % NXCD, off = wgid / NXCD; wgid = (xcd < r ? xcd * (q + 1) : r * (q + 1) + (xcd - r) * q) + off; }
        const int nig = WGM * nN, gid = wgid / nig, fm = gid * WGM, gsz = (nM - fm) < WGM ? (nM - fm) : WGM;
        u.pm = fm + ((wgid % nig) % gsz); u.pn = (wgid % nig) / gsz; return true;
    }
    __device__ __forceinline__ void a_ready(const Unit&) const {}
    __device__ __forceinline__ void done(const Unit&) const {}
};

__device__ __forceinline__ unsigned cvt_pk_bf16(float lo, float hi) { unsigned r; asm volatile("v_cvt_pk_bf16_f32 %0, %1, %2" : "=v"(r) : "v"(lo), "v"(hi)); return r; }
typedef float f32x2 __attribute__((ext_vector_type(2)));
typedef unsigned u32x2 __attribute__((ext_vector_type(2)));
__device__ __forceinline__ float xsum_fq(float s) { s += __shfl_xor(s, 16); s += __shfl_xor(s, 32); return s; }

struct EpiQKV {
    static constexpr bool PERM = true, AFTER_DRAIN = false;
    bf16_t* O; const float* gtab; const float* rcos; const float* rsin; float qscale; float* kpart;
    __device__ __forceinline__ void operator()(const f32x4 (&acc)[2][2][4][2], const Unit& u, int wr, int wc, int fr_, int fq_) const {
        int fr = fr_, fq = fq_; asm volatile("" : "+v"(fr), "+v"(fq));
        const int t = u.pn >> 1;
        const int hh = u.pn * 4 + wc;
        const int row0 = u.pm * BM + wr * 64 + fr;
        if (t == 2 || t == 5) {
#pragma unroll
            for (int ai = 0; ai < 2; ++ai)
#pragma unroll
                for (int m = 0; m < 4; ++m) { const int row = row0 + ai * HALF + m * 16; bf16_t* rowp = O + ((size_t)((row >> 13) * 48 + hh) * 8192 + (row & 8191)) * 64 + 8 * fq;
#pragma unroll
                    for (int bj = 0; bj < 2; ++bj) { const f32x4 v0 = acc[ai][bj][m][0], v1 = acc[ai][bj][m][1]; u32x4 w;
                        w.x = cvt_pk_bf16(v0[0], v0[1]); w.y = cvt_pk_bf16(v0[2], v0[3]); w.z = cvt_pk_bf16(v1[0], v1[1]); w.w = cvt_pk_bf16(v1[2], v1[3]);
                        *(u32x4*)(rowp + bj * 32) = w; } }
        } else {
            const float* g = gtab + t * 64;
            const float sc = (t == 0 || t == 3) ? qscale : 1.0f;
            f32x4 gv[2][2];
#pragma unroll
            for (int bj = 0; bj < 2; ++bj)
#pragma unroll
                for (int n = 0; n < 2; ++n) gv[bj][n] = *(const f32x4*)(g + 32 * bj + 8 * fq + 4 * n) * sc;
#pragma unroll
            for (int ai = 0; ai < 2; ++ai)
#pragma unroll
                for (int m = 0; m < 4; ++m) {
                    const int row = row0 + ai * HALF + m * 16; const int pos = row & 8191;
                    float ss = 0.f;
#pragma unroll
                    for (int bj = 0; bj < 2; ++bj)
#pragma unroll
                        for (int n = 0; n < 2; ++n) { const f32x4 x = acc[ai][bj][m][n]; ss += (x[0] * x[0] + x[1] * x[1]) + (x[2] * x[2] + x[3] * x[3]); }
                    ss = xsum_fq(ss);
                    const float rstd = __builtin_amdgcn_rsqf(ss * (1.0f / 64.0f) + 1e-6f);
                    u32x4 wlo, whi;
#pragma unroll
                    for (int n = 0; n < 2; ++n) {
                        const f32x4 c = *(const f32x4*)(rcos + pos * 32 + 8 * fq + 4 * n), s = *(const f32x4*)(rsin + pos * 32 + 8 * fq + 4 * n);
                        const f32x4 lo = acc[ai][0][m][n] * rstd * gv[0][n], hi = acc[ai][1][m][n] * rstd * gv[1][n];
                        const f32x4 olo = lo * c - hi * s, ohi = hi * c + lo * s;
                        if (n == 0) { wlo.x = cvt_pk_bf16(olo[0], olo[1]); wlo.y = cvt_pk_bf16(olo[2], olo[3]); whi.x = cvt_pk_bf16(ohi[0], ohi[1]); whi.y = cvt_pk_bf16(ohi[2], ohi[3]); }
                        else        { wlo.z = cvt_pk_bf16(olo[0], olo[1]); wlo.w = cvt_pk_bf16(olo[2], olo[3]); whi.z = cvt_pk_bf16(ohi[0], ohi[1]); whi.w = cvt_pk_bf16(ohi[2], ohi[3]); }
                    }
                    bf16_t* rowp = O + ((size_t)((row >> 13) * 48 + hh) * 8192 + pos) * 64 + 8 * fq;
                    *(u32x4*)(rowp) = wlo; *(u32x4*)(rowp + 32) = whi;
                }
            if (t == 1) {
                asm volatile("" ::: "memory");
                f32x4 cs[2][2];
#pragma unroll
                for (int bj = 0; bj < 2; ++bj)
#pragma unroll
                    for (int n = 0; n < 2; ++n) cs[bj][n] = (f32x4){0.f, 0.f, 0.f, 0.f};
#pragma unroll
                for (int ai = 0; ai < 2; ++ai)
#pragma unroll
                    for (int m = 0; m < 4; ++m) {
                        const int row = row0 + ai * HALF + m * 16; const int pos = row & 8191;
                        float ss = 0.f;
#pragma unroll
                        for (int bj = 0; bj < 2; ++bj)
#pragma unroll
                            for (int n = 0; n < 2; ++n) { const f32x4 x = acc[ai][bj][m][n]; ss += (x[0] * x[0] + x[1] * x[1]) + (x[2] * x[2] + x[3] * x[3]); }
                        ss = xsum_fq(ss);
                        const float rstd = __builtin_amdgcn_rsqf(ss * (1.0f / 64.0f) + 1e-6f);
#pragma unroll
                        for (int n = 0; n < 2; ++n) {
                            const f32x4 c = *(const f32x4*)(rcos + pos * 32 + 8 * fq + 4 * n), sn = *(const f32x4*)(rsin + pos * 32 + 8 * fq + 4 * n);
                            const f32x4 lo = acc[ai][0][m][n] * rstd * gv[0][n], hi = acc[ai][1][m][n] * rstd * gv[1][n];
                            cs[0][n] += lo * c - hi * sn; cs[1][n] += hi * c + lo * sn;
                        }
                        asm volatile("" ::: "memory");
                    }
#pragma unroll
                for (int bj = 0; bj < 2; ++bj)
#pragma unroll
                    for (int n = 0; n < 2; ++n)
#pragma unroll
                        for (int j = 0; j < 4; ++j) { float v = cs[bj][n][j]; v += __shfl_xor(v, 1); v += __shfl_xor(v, 2); v += __shfl_xor(v, 4); v += __shfl_xor(v, 8); cs[bj][n][j] = v; }
                if (fr == 0) { float* kp = kpart + ((size_t)(((u.pm >> 5) * 8 + (hh - 8)) * 32 + (u.pm & 31)) * 2 + wr) * 64 + 8 * fq;
                    *(f32x4*)(kp) = cs[0][0]; *(f32x4*)(kp + 4) = cs[0][1]; *(f32x4*)(kp + 32) = cs[1][0]; *(f32x4*)(kp + 36) = cs[1][1]; }
            }
        }
    }
};
struct EpiOut {
    static constexpr bool PERM = true, AFTER_DRAIN = false;
    const float* X; bf16_t* XB; float* SS;
    __device__ __forceinline__ void operator()(const f32x4 (&acc)[2][2][4][2], const Unit& u, int wr, int wc, int fr, int fq) const {
        const int col0 = u.pn * 256 + wc * 32 + 8 * fq;
        const int row0 = u.pm * BM + wr * 64 + fr;
#pragma unroll
        for (int ai = 0; ai < 2; ++ai)
#pragma unroll
            for (int m = 0; m < 4; ++m) { const int row = row0 + ai * HALF + m * 16; const size_t off = (size_t)row * 1024 + col0; float ss = 0.f;
#pragma unroll
                for (int bj = 0; bj < 2; ++bj) {
                    const f32x4 v0 = __builtin_nontemporal_load((const f32x4*)(X + off + bj * HALF)) + acc[ai][bj][m][0], v1 = __builtin_nontemporal_load((const f32x4*)(X + off + bj * HALF + 4)) + acc[ai][bj][m][1];
                    ss += (v0[0] * v0[0] + v0[1] * v0[1]) + (v0[2] * v0[2] + v0[3] * v0[3]) + (v1[0] * v1[0] + v1[1] * v1[1]) + (v1[2] * v1[2] + v1[3] * v1[3]);
                    u32x4 w; w.x = cvt_pk_bf16(v0[0], v0[1]); w.y = cvt_pk_bf16(v0[2], v0[3]); w.z = cvt_pk_bf16(v1[0], v1[1]); w.w = cvt_pk_bf16(v1[2], v1[3]);
                    *(u32x4*)(XB + off + bj * HALF) = w; }
                ss = xsum_fq(ss);
                if (fq == 0) SS[(size_t)row * 16 + u.pn * 4 + wc] = ss; }
    }
};
struct EpiSwiGLU {
    static constexpr bool PERM = true, AFTER_DRAIN = false;
    const float* SS; bf16_t* H;
    __device__ __forceinline__ void operator()(const f32x4 (&acc)[2][2][4][2], const Unit& u, int wr, int wc, int fr, int fq) const {
        const int col0 = u.pn * 128 + wc * 32 + 8 * fq;
        const int row0 = u.pm * BM + wr * 64 + fr;
#pragma unroll
        for (int ai = 0; ai < 2; ++ai)
#pragma unroll
            for (int m = 0; m < 4; ++m) { const int row = row0 + ai * HALF + m * 16;
                const f32x4* sp = (const f32x4*)(SS + (size_t)row * 16); const f32x4 a = sp[0], b = sp[1], c = sp[2], d = sp[3];
                const float tot = ((a[0] + a[1]) + (a[2] + a[3])) + ((b[0] + b[1]) + (b[2] + b[3])) + ((c[0] + c[1]) + (c[2] + c[3])) + ((d[0] + d[1]) + (d[2] + d[3]));
                const float rstd = __builtin_amdgcn_rsqf(tot * (1.0f / 1024.0f) + 1e-6f);
                unsigned w[4];
                const float rneg = -1.4426950408889634f * rstd, r2 = rstd * rstd;
#pragma unroll
                for (int n = 0; n < 2; ++n) { const f32x4 ga = acc[ai][0][m][n], gu = ga * acc[ai][1][m][n] * r2, ea = ga * rneg; float h[4];
#pragma unroll
                    for (int j = 0; j < 4; ++j) h[j] = gu[j] * __builtin_amdgcn_rcpf(1.0f + __builtin_amdgcn_exp2f(ea[j]));
                    w[2 * n] = cvt_pk_bf16(h[0], h[1]); w[2 * n + 1] = cvt_pk_bf16(h[2], h[3]); }
                *(u32x4*)(H + (size_t)row * 2816 + col0) = (u32x4){w[0], w[1], w[2], w[3]}; }
    }
};
struct EpiDown {
    static constexpr bool PERM = true, AFTER_DRAIN = false;
    const bf16_t* XB; float* Y;
    __device__ __forceinline__ void operator()(const f32x4 (&acc)[2][2][4][2], const Unit& u, int wr, int wc, int fr, int fq) const {
        const int col0 = u.pn * 256 + wc * 32 + 8 * fq;
        const int row0 = u.pm * BM + wr * 64 + fr;
#pragma unroll
        for (int ai = 0; ai < 2; ++ai)
#pragma unroll
            for (int m = 0; m < 4; ++m) { const size_t off = (size_t)(row0 + ai * HALF + m * 16) * 1024 + col0;
#pragma unroll
                for (int bj = 0; bj < 2; ++bj) {
                    const u32x4 xb = __builtin_nontemporal_load((const u32x4*)(XB + off + bj * HALF));
                    const f32x4 x0 = {__builtin_bit_cast(float, xb.x << 16), __builtin_bit_cast(float, xb.x & 0xffff0000u), __builtin_bit_cast(float, xb.y << 16), __builtin_bit_cast(float, xb.y & 0xffff0000u)};
                    const f32x4 x1 = {__builtin_bit_cast(float, xb.z << 16), __builtin_bit_cast(float, xb.z & 0xffff0000u), __builtin_bit_cast(float, xb.w << 16), __builtin_bit_cast(float, xb.w & 0xffff0000u)};
                    const f32x4 v0 = x0 + acc[ai][bj][m][0], v1 = x1 + acc[ai][bj][m][1];
                    __builtin_nontemporal_store(v0, (f32x4*)(Y + off + bj * HALF)); __builtin_nontemporal_store(v1, (f32x4*)(Y + off + bj * HALF + 4)); } }
    }
};

template <class Epi, class Sched, bool ALIGN_EPI = false, bool SP2 = false>
__device__ __forceinline__ void gemm_phase(PG8_LAS unsigned char* lds, const Gemm g, const Sched& S, const Epi& E) {
    int tid_ = threadIdx.x; asm volatile("" : "+v"(tid_));
    const int tid = tid_, wid = __builtin_amdgcn_readfirstlane(tid >> 6), lane = tid & 63, wr = wid >> 2, wc = wid & 3, fr = lane & 15, fq = lane >> 4;
    const int K = g.K, nt = K / BK;
    unsigned voffA[2], voffB[2];
#pragma unroll
    for (int i = 0; i < 2; ++i) { int R, C; stage_rc(tid * 16 + i * 8192, R, C); const int Rb = Epi::PERM ? ((R & ~31) + perm32(R & 31)) : R;
        voffA[i] = (unsigned)(R * K + C) * 2u; voffB[i] = (unsigned)(Rb * K + C) * 2u; }
    const size_t kstep = (size_t)(BK * 2);
    const size_t hstep = (size_t)HALF * K * 2;
    const size_t tstep = 2 * hstep;
    const unsigned ldsw = (unsigned)wid * 1024u;
    const int aoff = lds_byte(wr * 64 + fr, fq * 8), boff = lds_byte(wc * 32 + fr, fq * 8);
#define PG8_SA(b, h) (((b) * 2 + (h)) * HTB)
#define PG8_SB(b, h) ((4 + (b) * 2 + (h)) * HTB)
#define PG8_STAGE(bufoff, gbase, voff) do { _Pragma("unroll") for (int _i = 0; _i < 2; ++_i) \
        __builtin_amdgcn_global_load_lds((const unsigned*)((const char*)(gbase) + (voff)[_i]), (PG8_LAS unsigned*)(lds + (bufoff) + ldsw + _i * 8192), 16, 0, 0); } while (0)
#define PG8_LDA(dst, b, h) do { _Pragma("unroll") for (int m = 0; m < 4; ++m) _Pragma("unroll") for (int k = 0; k < 2; ++k) dst[m][k] = *(const PG8_LAS bf16x8*)(lds + PG8_SA(b, h) + aoff + m * 2048 + k * 1024); } while (0)
#define PG8_LDB(dst, b, h) do { _Pragma("unroll") for (int n = 0; n < 2; ++n) _Pragma("unroll") for (int k = 0; k < 2; ++k) dst[n][k] = *(const PG8_LAS bf16x8*)(lds + PG8_SB(b, h) + boff + n * 2048 + k * 1024); } while (0)
#define PG8_MMA(ai, bj, At, Bt) do { __builtin_amdgcn_s_setprio(1); _Pragma("unroll") for (int m = 0; m < 4; ++m) _Pragma("unroll") for (int n = 0; n < 2; ++n) _Pragma("unroll") for (int k = 0; k < 2; ++k) \
        acc[ai][bj][m][n] = __builtin_amdgcn_mfma_f32_16x16x32_bf16(Bt[n][k], At[m][k], acc[ai][bj][m][n], 0, 0, 0); __builtin_amdgcn_s_setprio(0); } while (0)
#define PG8_WAIT_V(n) asm volatile("s_waitcnt vmcnt(" #n ")" ::: "memory")
#define PG8_WAIT_L(n) asm volatile("s_waitcnt lgkmcnt(" #n ")" ::: "memory")
#define PG8_BAR __builtin_amdgcn_s_barrier()
#define PG8_SCHED __builtin_amdgcn_sched_barrier(0)
    Unit cur, nxt; int ui = 0;
    if (!S.next(0, cur)) return;
    f32x4 acc[2][2][4][2];
#pragma unroll
    for (int a = 0; a < 2; ++a)
#pragma unroll
        for (int b = 0; b < 2; ++b)
#pragma unroll
            for (int m = 0; m < 4; ++m)
#pragma unroll
                for (int n = 0; n < 2; ++n) acc[a][b][m][n] = (f32x4){0.f, 0.f, 0.f, 0.f};
    bf16x8 At[4][2], B0[2][2], B1[2][2];
    const char* cA = (const char*)g.A + (size_t)cur.pm * tstep; const char* cB = (const char*)g.Bt + (size_t)cur.pn * tstep;
    S.a_ready(cur);
    if constexpr (SP2) {
        PG8_STAGE(PG8_SB(0, 0), cB, voffB); PG8_STAGE(PG8_SB(0, 1), cB + hstep, voffB); PG8_STAGE(PG8_SA(0, 0), cA, voffA); PG8_STAGE(PG8_SA(0, 1), cA + hstep, voffA);
        if (wr == 1) PG8_BAR;
        PG8_WAIT_V(2); PG8_BAR;
        PG8_STAGE(PG8_SB(1, 0), cB + kstep, voffB); PG8_STAGE(PG8_SA(1, 0), cA + kstep, voffA); PG8_STAGE(PG8_SB(1, 1), cB + hstep + kstep, voffB);
        PG8_WAIT_V(6); PG8_BAR;
    } else {
        PG8_STAGE(PG8_SB(0, 0), cB, voffB); PG8_STAGE(PG8_SA(0, 0), cA, voffA); PG8_STAGE(PG8_SB(0, 1), cB + hstep, voffB); PG8_STAGE(PG8_SA(0, 1), cA + hstep, voffA);
        if (wr == 1) PG8_BAR;
        PG8_WAIT_V(4); PG8_BAR;
        PG8_STAGE(PG8_SB(1, 0), cB + kstep, voffB); PG8_STAGE(PG8_SA(1, 0), cA + kstep, voffA); PG8_STAGE(PG8_SB(1, 1), cB + hstep + kstep, voffB);
        PG8_WAIT_V(6); PG8_BAR;
    }
    for (;;) {
        const bool has_next = S.next(ui + 1, nxt);
        const char* nA = has_next ? (const char*)g.A + (size_t)nxt.pm * tstep : cA; const char* nB = has_next ? (const char*)g.Bt + (size_t)nxt.pn * tstep : cB;
        for (int t = 0; t < nt; t += 2) {
            const bool last = (t == nt - 2);
            const char* a1 = cA + (size_t)(t + 1) * kstep;
            const char* a2 = last ? nA : cA + (size_t)(t + 2) * kstep; const char* b2 = last ? nB : cB + (size_t)(t + 2) * kstep;
            const char* a3 = a2 + kstep; const char* b3 = b2 + kstep;
            if (last && has_next) S.a_ready(nxt);
            if constexpr (SP2) {
            PG8_LDB(B0, 0, 0); PG8_LDB(B1, 0, 1); PG8_SCHED; PG8_LDA(At, 0, 0); PG8_STAGE(PG8_SA(1, 1), a1 + hstep, voffA);
            PG8_WAIT_V(8); PG8_WAIT_L(0); PG8_BAR; PG8_MMA(0, 0, At, B0); PG8_MMA(0, 1, At, B1); PG8_BAR; PG8_SCHED;
            PG8_LDA(At, 0, 1); PG8_STAGE(PG8_SB(0, 0), b2, voffB); PG8_STAGE(PG8_SB(0, 1), b2 + hstep, voffB); PG8_STAGE(PG8_SA(0, 0), a2, voffA);
            PG8_WAIT_V(8); PG8_WAIT_L(0); PG8_BAR; PG8_MMA(1, 0, At, B0); PG8_MMA(1, 1, At, B1); PG8_BAR; PG8_SCHED;
            PG8_LDB(B0, 1, 0); PG8_LDB(B1, 1, 1); PG8_SCHED; PG8_LDA(At, 1, 0); PG8_STAGE(PG8_SA(0, 1), a2 + hstep, voffA);
            PG8_WAIT_V(8); PG8_WAIT_L(0); PG8_BAR; PG8_MMA(0, 0, At, B0); PG8_MMA(0, 1, At, B1); PG8_BAR; PG8_SCHED;
            PG8_LDA(At, 1, 1); PG8_STAGE(PG8_SB(1, 0), b3, voffB); PG8_STAGE(PG8_SB(1, 1), b3 + hstep, voffB); PG8_STAGE(PG8_SA(1, 0), a3, voffA);
            PG8_WAIT_V(8); PG8_WAIT_L(0); PG8_BAR; PG8_MMA(1, 0, At, B0); PG8_MMA(1, 1, At, B1); PG8_BAR; PG8_SCHED;
            } else {
            PG8_LDB(B0, 0, 0); PG8_SCHED; PG8_LDA(At, 0, 0); PG8_STAGE(PG8_SA(1, 1), a1 + hstep, voffA);
            PG8_WAIT_L(8); PG8_BAR; PG8_WAIT_L(0); PG8_MMA(0, 0, At, B0); PG8_BAR; PG8_SCHED;
            PG8_LDB(B1, 0, 1); PG8_STAGE(PG8_SB(0, 0), b2, voffB);
            PG8_BAR; PG8_WAIT_L(0); PG8_MMA(0, 1, At, B1); PG8_BAR;
            PG8_LDA(At, 0, 1); PG8_STAGE(PG8_SA(0, 0), a2, voffA);
            PG8_BAR; PG8_WAIT_L(0); PG8_MMA(1, 0, At, B0); PG8_BAR; PG8_SCHED;
            PG8_STAGE(PG8_SB(0, 1), b2 + hstep, voffB);
            PG8_WAIT_V(6); PG8_BAR; PG8_MMA(1, 1, At, B1); PG8_BAR;
            PG8_LDB(B0, 1, 0); PG8_SCHED; PG8_LDA(At, 1, 0); PG8_STAGE(PG8_SA(0, 1), a2 + hstep, voffA);
            PG8_WAIT_L(8); PG8_BAR; PG8_WAIT_L(0); PG8_MMA(0, 0, At, B0); PG8_BAR; PG8_SCHED;
            PG8_LDB(B1, 1, 1); PG8_STAGE(PG8_SB(1, 0), b3, voffB);
            PG8_BAR; PG8_WAIT_L(0); PG8_MMA(0, 1, At, B1); PG8_BAR;
            PG8_LDA(At, 1, 1); PG8_STAGE(PG8_SA(1, 0), a3, voffA);
            PG8_BAR; PG8_WAIT_L(0); PG8_MMA(1, 0, At, B0); PG8_BAR; PG8_SCHED;
            PG8_STAGE(PG8_SB(1, 1), b3 + hstep, voffB);
            PG8_WAIT_V(6); PG8_BAR; PG8_MMA(1, 1, At, B1); PG8_BAR;
            }
        }
        if constexpr (ALIGN_EPI) { if (wr == 0) PG8_BAR; }
        if constexpr (!Epi::AFTER_DRAIN) { E(acc, cur, wr, wc, fr, fq); S.done(cur); }
        if (!has_next) break;
#pragma unroll
        for (int a = 0; a < 2; ++a)
#pragma unroll
            for (int b = 0; b < 2; ++b)
#pragma unroll
                for (int m = 0; m < 4; ++m)
#pragma unroll
                    for (int n = 0; n < 2; ++n) acc[a][b][m][n] = (f32x4){0.f, 0.f, 0.f, 0.f};
        cur = nxt; cA = nA; cB = nB; ++ui;
        if constexpr (ALIGN_EPI) { if (wr == 1) PG8_BAR; }
    }
    PG8_WAIT_V(0);
    if constexpr (!ALIGN_EPI) { if (wr == 0) PG8_BAR; }
    PG8_BAR;
    if constexpr (Epi::AFTER_DRAIN) { E.fused(acc, cur, wr, wc, fr, fq, lds, wid, lane); S.done(cur); }
#undef PG8_SA
#undef PG8_SB
#undef PG8_STAGE
#undef PG8_LDA
#undef PG8_LDB
#undef PG8_MMA
#undef PG8_WAIT_V
#undef PG8_WAIT_L
#undef PG8_BAR
#undef PG8_SCHED
}
}

#ifndef PG8_SP2
#define PG8_SP2 true
#endif
#ifndef PG8_ALIGN
#define PG8_ALIGN true
#endif
#include <hip/hip_bf16.h>
#include <cmath>
namespace attn_body {
using bf16=__hip_bfloat16;
using bf16x8=__attribute__((ext_vector_type(8)))short;
using s16x4=__attribute__((ext_vector_type(4)))short;
using f32x16=__attribute__((ext_vector_type(16)))float;
using u32x4=__attribute__((ext_vector_type(4)))unsigned;
constexpr int SEQ=8192,D=64,PQ=64,PO=1024;
constexpr int NW=8,QBLK=32,QB=QBLK*NW,KVBLK=64,NQB=SEQ/QB;
constexpr int ATTN_UNIT_ROWS=QB;
__device__ __forceinline__ int crow(int r,int hi){return (r&3)+8*(r>>2)+4*hi;}
#define SBAR() __builtin_amdgcn_sched_barrier(0)
__device__ __forceinline__ void cmask(f32x16&p0,f32x16&p1,int jb,int qrel,int hi){
  const float NEG=-INFINITY; int kb=64*jb+4*hi;
  #pragma unroll
  for(int r=0;r<16;++r){int kv=kb+(r&3)+8*(r>>2); if(kv>qrel)p0[r]=NEG; if(kv+32>qrel)p1[r]=NEG;}
}

constexpr int NSLOT=3, SLOTB=8192;
constexpr int LDS_K=0, LDS_V=NSLOT*SLOTB, LDS_WS=2*NSLOT*SLOTB, LDS_OST=LDS_WS+NW*64*4, LDS_BYTES=LDS_OST+NW*4096;
constexpr float C2=0.125f*1.4426950408889634f;
__device__ __forceinline__ void glds16(const void*gsrc,unsigned lds_dst){unsigned keep;
  asm volatile("s_mov_b32 %0, m0\n\ts_mov_b32 m0, %2\n\ts_nop 0\n\tglobal_load_lds_dwordx4 %1, off\n\ts_mov_b32 m0, %0":"=&s"(keep):"v"(gsrc),"s"(lds_dst):"memory");}
__device__ __forceinline__ float max3f(float a,float b,float c){float r;asm("v_max3_f32 %0, %1, %2, %3":"=v"(r):"v"(a),"v"(b),"v"(c));return r;}
__device__ __forceinline__ float max2f(float a,float b){float r;asm("v_max_f32_e32 %0, %1, %2":"=v"(r):"v"(a),"v"(b));return r;}
__device__ __forceinline__ float fadd_s(float a,float b){float r;asm("v_add_f32_e32 %0, %1, %2":"=v"(r):"v"(a),"v"(b));return r;}
__device__ __forceinline__ float fsub_s(float a,float b){float r;asm("v_sub_f32_e32 %0, %1, %2":"=v"(r):"v"(a),"v"(b));return r;}
typedef float f32x2_t __attribute__((ext_vector_type(2))); typedef __bf16 bf16x2_t __attribute__((ext_vector_type(2)));
__device__ __forceinline__ unsigned cvtpk_s(float lo,float hi){f32x2_t v={lo,hi};bf16x2_t b=__builtin_convertvector(v,bf16x2_t);return __builtin_bit_cast(unsigned,b);}
#define WAIT_BAR(N) asm volatile("s_waitcnt vmcnt(" #N ") lgkmcnt(0)\n\ts_barrier":::"memory")

__device__ __forceinline__ void qkt(f32x16&p0,f32x16&p1,const char*Kslot,const bf16x8*qr,const f32x16&negm,int r32,int hi){
  const char*kb=Kslot+hi*1024+r32*16;
  #pragma unroll
  for(int d0=0;d0<4;++d0){
    const bf16x8 b0=*reinterpret_cast<const bf16x8*>(kb+d0*2048);
    const bf16x8 b1=*reinterpret_cast<const bf16x8*>(kb+d0*2048+512);
    if(d0==0){p0=__builtin_amdgcn_mfma_f32_32x32x16_bf16(b0,qr[0],negm,0,0,0);p1=__builtin_amdgcn_mfma_f32_32x32x16_bf16(b1,qr[0],negm,0,0,0);}
    else{p0=__builtin_amdgcn_mfma_f32_32x32x16_bf16(b0,qr[d0],p0,0,0,0);p1=__builtin_amdgcn_mfma_f32_32x32x16_bf16(b1,qr[d0],p1,0,0,0);}}
}
typedef __attribute__((address_space(3))) const char* lds_cptr;
typedef short v4i16_t __attribute__((ext_vector_type(4)));
__device__ __forceinline__ void kload8(bf16x8*kf,lds_cptr kp){
  kf[0]=*(const __attribute__((address_space(3))) bf16x8*)(kp);      kf[1]=*(const __attribute__((address_space(3))) bf16x8*)(kp+512);
  kf[2]=*(const __attribute__((address_space(3))) bf16x8*)(kp+2048); kf[3]=*(const __attribute__((address_space(3))) bf16x8*)(kp+2560);
  kf[4]=*(const __attribute__((address_space(3))) bf16x8*)(kp+4096); kf[5]=*(const __attribute__((address_space(3))) bf16x8*)(kp+4608);
  kf[6]=*(const __attribute__((address_space(3))) bf16x8*)(kp+6144); kf[7]=*(const __attribute__((address_space(3))) bf16x8*)(kp+6656);
}
__device__ __forceinline__ void kload2(bf16x8*kf,lds_cptr kp,int j){ kf[2*j]=*(const __attribute__((address_space(3))) bf16x8*)(kp+j*2048); kf[2*j+1]=*(const __attribute__((address_space(3))) bf16x8*)(kp+j*2048+512); }
__device__ __forceinline__ s16x4 vtr(lds_cptr p){ return __builtin_bit_cast(s16x4,__builtin_amdgcn_ds_read_tr16_b64_v4i16((__attribute__((address_space(3))) v4i16_t*)p)); }
__device__ __forceinline__ float rowmax(const f32x16&p0,const f32x16&p1){
  float a=max3f(p0[0],p0[1],p1[0]),b=max3f(p0[2],p0[3],p1[1]);a=max3f(a,p1[2],p1[3]);
  #pragma unroll
  for(int r=4;r<16;r+=4){a=max3f(a,p0[r],p0[r+1]);b=max3f(b,p0[r+2],p0[r+3]);a=max3f(a,p1[r],p1[r+1]);b=max3f(b,p1[r+2],p1[r+3]);}
  const float m=max2f(a,b);
  auto rr=__builtin_amdgcn_permlane32_swap(__float_as_uint(m),__float_as_uint(m),false,false);
  return max2f(__uint_as_float(rr[0]),__uint_as_float(rr[1]));
}
__device__ __forceinline__ void pv(f32x16*o,int vb,bf16x8 pa0,bf16x8 pa1,bf16x8 pa2,bf16x8 pa3){
  #pragma unroll
  for(int d0=0;d0<2;++d0){s16x4 lo[4],hi[4];
    #pragma unroll
    for(int ks=0;ks<4;++ks){
      asm volatile("ds_read_b64_tr_b16 %0,%1 offset:%c2":"=&v"(lo[ks]):"v"(vb),"i"(d0*4096+ks*1024):"memory");
      asm volatile("ds_read_b64_tr_b16 %0,%1 offset:%c2":"=&v"(hi[ks]):"v"(vb),"i"(d0*4096+ks*1024+512):"memory");}
    asm volatile("s_waitcnt lgkmcnt(0)":::"memory");SBAR();
    #define PK(k) (bf16x8){lo[k][0],lo[k][1],lo[k][2],lo[k][3],hi[k][0],hi[k][1],hi[k][2],hi[k][3]}
    o[d0]=__builtin_amdgcn_mfma_f32_32x32x16_bf16(pa0,PK(0),o[d0],0,0,0);
    o[d0]=__builtin_amdgcn_mfma_f32_32x32x16_bf16(pa1,PK(1),o[d0],0,0,0);
    o[d0]=__builtin_amdgcn_mfma_f32_32x32x16_bf16(pa2,PK(2),o[d0],0,0,0);
    o[d0]=__builtin_amdgcn_mfma_f32_32x32x16_bf16(pa3,PK(3),o[d0],0,0,0);
    #undef PK
  }
}

__device__ __forceinline__ void pv2(f32x16&oa,f32x16&ob,int vb,bf16x8 pa0,bf16x8 pa1,bf16x8 pa2,bf16x8 pa3){
  #pragma unroll
  for(int d0=0;d0<2;++d0){s16x4 lo[4],hi[4];
    #pragma unroll
    for(int ks=0;ks<4;++ks){
      asm volatile("ds_read_b64_tr_b16 %0,%1 offset:%c2":"=&v"(lo[ks]):"v"(vb),"i"(d0*4096+ks*1024):"memory");
      asm volatile("ds_read_b64_tr_b16 %0,%1 offset:%c2":"=&v"(hi[ks]):"v"(vb),"i"(d0*4096+ks*1024+512):"memory");}
    asm volatile("s_waitcnt lgkmcnt(0)":::"memory");SBAR();
    #define PK(k) (bf16x8){lo[k][0],lo[k][1],lo[k][2],lo[k][3],hi[k][0],hi[k][1],hi[k][2],hi[k][3]}
    f32x16 acc=d0?ob:oa;
    acc=__builtin_amdgcn_mfma_f32_32x32x16_bf16(pa0,PK(0),acc,0,0,0);
    acc=__builtin_amdgcn_mfma_f32_32x32x16_bf16(pa1,PK(1),acc,0,0,0);
    acc=__builtin_amdgcn_mfma_f32_32x32x16_bf16(pa2,PK(2),acc,0,0,0);
    acc=__builtin_amdgcn_mfma_f32_32x32x16_bf16(pa3,PK(3),acc,0,0,0);
    if(d0)ob=acc;else oa=acc;
    #undef PK
  }
}
#ifndef ATTN_STORE16
#define ATTN_STORE16(p,v) (*(u32x4*)(p)=(v))
#endif
template<int THRL> __device__ __forceinline__ void attn_unit(int qb,const bf16*Qh,const bf16*__restrict__ Kh,const bf16*__restrict__ Vh,bf16*Oh,char*shm,unsigned selmask){
  int tid_=threadIdx.x; asm volatile("":"+v"(tid_)); const int tid=tid_,lane=tid&63,r32=lane&31,hi=lane>>5; const int wid=__builtin_amdgcn_readfirstlane(tid>>6);
  const int q0=qb*QB;
  const bf16*Qw=Qh+(long)(q0+wid*QBLK)*PQ;
  const unsigned lds0=(unsigned)(uintptr_t)shm;
  float*wsf=(float*)(shm+LDS_WS)+wid*64;
  const bf16*ksrc=Kh+(long)lane*PQ+wid*8;
  const bf16*vsrc=Vh+(long)(16*(wid&3)+(lane>>2))*PQ+(wid>>2)*32+(lane&3)*8;
  const unsigned kdst=lds0+LDS_K+wid*1024, vdst=lds0+LDS_V+wid*1024;
  #define DMA_K(t,slot) glds16(ksrc+(long)(t)*KVBLK*PQ,(unsigned)__builtin_amdgcn_readfirstlane(kdst+(slot)))
  #define DMA_V(t,slot) glds16(vsrc+(long)(t)*KVBLK*PQ,(unsigned)__builtin_amdgcn_readfirstlane(vdst+(slot)))
  const int vb0=(int)(lds0+LDS_V)+((lane>>4)&1)*32+(lane&3)*8+(4*hi+((lane&15)>>2))*64;
  const char*Kbase=shm+LDS_K; bf16x8 kf[8];
  const lds_cptr shm3=(lds_cptr)shm; const lds_cptr kp0=shm3+LDS_K+hi*1024+r32*16; const lds_cptr vp0=shm3+LDS_V+((lane>>4)&1)*32+(lane&3)*8+(4*hi+((lane&15)>>2))*64;
  const int NT=(q0+QB)/KVBLK;
  DMA_K(0,0);DMA_V(0,0);DMA_K(1,SLOTB);
  bf16x8 qr[4];
  #pragma unroll
  for(int d0=0;d0<4;++d0)qr[d0]=*reinterpret_cast<const bf16x8*>(&Qw[(long)r32*PQ+d0*16+hi*8]);
  float l_reg=0.f;f32x16 o[2];o[0]=f32x16{};o[1]=f32x16{};f32x16 negm;
  #define SETBIAS(t) do{ const float bv_=((selmask>>((t)>>2))&1u)?0.f:-INFINITY; _Pragma("unroll") for(int r_=0;r_<16;++r_)negm[r_]=bv_; asm volatile("":"+v"(negm)); }while(0)
  SETBIAS(0);
  const int qrel=wid*QBLK+r32;
  #define CMASK(P0,P1,t) do{int jb_=(t)-(NT-4); if(jb_>=0)cmask(P0,P1,jb_,qrel,hi);}while(0)
  #define START(P0,P1) do{ _Pragma("unroll") for(int r=0;r<16;++r)P0[r]=__builtin_amdgcn_exp2f(P0[r]); }while(0)
  #define RESC() do{}while(0)
  f32x16 pA0,pA1,pB0,pB1;
  int sl_prev=0,sl_cur=0,sl_next=SLOTB;
  #define ROT() do{sl_prev=sl_cur;sl_cur=sl_next;sl_next=(sl_next==(NSLOT-1)*SLOTB)?0:sl_next+SLOTB;}while(0)
  DMA_K(2,2*SLOTB);
  WAIT_BAR(3);
  qkt(pA0,pA1,Kbase,qr,negm,r32,hi);asm volatile("s_nop 15\n\ts_nop 7":"+v"(pA0),"+v"(pA1));CMASK(pA0,pA1,0);
  START(pA0,pA1);
  _Pragma("unroll") for(int r=0;r<16;++r)pA1[r]=__builtin_amdgcn_exp2f(pA1[r]);
  WAIT_BAR(0);
  DMA_K(3,0);DMA_V(1,SLOTB);
  ROT();
  kload8(kf,kp0+sl_cur);
  WAIT_BAR(2);
  s16x4 vlo[8],vhi[8]; u32x4 pw0,pw1,pw2,pw3;
  #define PKW(P,B) cvtpk_s(P[B],P[B+1])
  #define PAF(k) __builtin_bit_cast(bf16x8,pw##k)
  #define VFR(i) (bf16x8){vlo[i][0],vlo[i][1],vlo[i][2],vlo[i][3],vhi[i][0],vhi[i][1],vhi[i][2],vhi[i][3]}
  #define PIN(x) asm volatile("":"+v"(x))
  #define MX3(a,b,c) __builtin_fmaxf(__builtin_fmaxf((a),(b)),(c))
  #define GAPA(MF,A0,A1,A2,A3,W0,W1,PW) do{ MF; sacc+=A0; sacc+=A1; sacc+=A2; sacc+=A3; PIN(sacc); W0; W1; PIN(PW); SBAR(); }while(0)
  #define EX(v) __builtin_amdgcn_exp2f(v)
  #define GAPB(MF,X,B) do{ MF; X[B]=EX(X[B]); X[B+1]=EX(X[B+1]); X[B+2]=EX(X[B+2]); X[B+3]=EX(X[B+3]); PIN(X); SBAR(); }while(0)
  #define VRD(i) do{ vlo[i]=vtr(vp_+(((i)>>2)*4096+((i)&3)*1024)); vhi[i]=vtr(vp_+(((i)>>2)*4096+((i)&3)*1024+512)); }while(0)
  #define KRD(G,j) do{ if(G){ kload2(kf,kp0+sl_next,j); SBAR(); } }while(0)
  #define STEP(C0,C1,P0,P1,t,GK,GV,GL) do{ SBAR(); if((((t))&3)==0){ SETBIAS(t); } SBAR(); \
    const lds_cptr vp_=vp0+sl_prev; \
    VRD(0); SBAR(); float sacc=(P0[0]+P0[1]); \
    GAPA(C0=__builtin_amdgcn_mfma_f32_32x32x16_bf16(kf[0],qr[0],negm,0,0,0), P0[2],P0[3],P0[4],P0[5],     pw0[0]=PKW(P0,0), pw0[1]=PKW(P0,2), pw0); \
    VRD(4); SBAR(); GAPA(C1=__builtin_amdgcn_mfma_f32_32x32x16_bf16(kf[1],qr[0],negm,0,0,0), P0[6],P0[7],P0[8],P0[9],     pw0[2]=PKW(P0,4), pw0[3]=PKW(P0,6), pw0); \
    VRD(1); SBAR(); GAPA(C0=__builtin_amdgcn_mfma_f32_32x32x16_bf16(kf[2],qr[1],C0,0,0,0),   P0[10],P0[11],P0[12],P0[13], pw1[0]=PKW(P0,8), pw1[1]=PKW(P0,10), pw1); \
    VRD(5); SBAR(); GAPA(C1=__builtin_amdgcn_mfma_f32_32x32x16_bf16(kf[3],qr[1],C1,0,0,0),   P0[14],P0[15],P1[0],P1[1],   pw1[2]=PKW(P0,12),pw1[3]=PKW(P0,14), pw1); \
    VRD(2); SBAR(); GAPA(C0=__builtin_amdgcn_mfma_f32_32x32x16_bf16(kf[4],qr[2],C0,0,0,0),   P1[2],P1[3],P1[4],P1[5],     pw2[0]=PKW(P1,0), pw2[1]=PKW(P1,2), pw2); \
    VRD(6); SBAR(); GAPA(C1=__builtin_amdgcn_mfma_f32_32x32x16_bf16(kf[5],qr[2],C1,0,0,0),   P1[6],P1[7],P1[8],P1[9],     pw2[2]=PKW(P1,4), pw2[3]=PKW(P1,6), pw2); \
    VRD(3); SBAR(); GAPA(C0=__builtin_amdgcn_mfma_f32_32x32x16_bf16(kf[6],qr[3],C0,0,0,0),   P1[10],P1[11],P1[12],P1[13], pw3[0]=PKW(P1,8), pw3[1]=PKW(P1,10), pw3); \
    VRD(7); SBAR(); GAPA(C1=__builtin_amdgcn_mfma_f32_32x32x16_bf16(kf[7],qr[3],C1,0,0,0),   P1[14],P1[15],0.f,0.f,       pw3[2]=PKW(P1,12),pw3[3]=PKW(P1,14), pw3); \
    l_reg+=sacc; \
    if(GK){DMA_K((t)+3,sl_cur);} if(GV){DMA_V((t)+1,sl_next);} \
    CMASK(C0,C1,t); \
    SBAR(); \
    GAPB(o[0]=__builtin_amdgcn_mfma_f32_32x32x16_bf16(PAF(0),VFR(0),o[0],0,0,0), C0,0); \
    GAPB(o[1]=__builtin_amdgcn_mfma_f32_32x32x16_bf16(PAF(0),VFR(4),o[1],0,0,0), C0,4); \
    KRD(GL,0); GAPB(o[0]=__builtin_amdgcn_mfma_f32_32x32x16_bf16(PAF(1),VFR(1),o[0],0,0,0), C0,8); \
    KRD(GL,1); GAPB(o[1]=__builtin_amdgcn_mfma_f32_32x32x16_bf16(PAF(1),VFR(5),o[1],0,0,0), C0,12); \
    KRD(GL,2); GAPB(o[0]=__builtin_amdgcn_mfma_f32_32x32x16_bf16(PAF(2),VFR(2),o[0],0,0,0), C1,0); \
    KRD(GL,3); GAPB(o[1]=__builtin_amdgcn_mfma_f32_32x32x16_bf16(PAF(2),VFR(6),o[1],0,0,0), C1,4); \
    GAPB(o[0]=__builtin_amdgcn_mfma_f32_32x32x16_bf16(PAF(3),VFR(3),o[0],0,0,0), C1,8); \
    GAPB(o[1]=__builtin_amdgcn_mfma_f32_32x32x16_bf16(PAF(3),VFR(7),o[1],0,0,0), C1,12); \
    }while(0)
  int t=1;
  #undef CMASK
  #define CMASK(P0,P1,t) do{}while(0)
  for(;t+5<NT;t+=2){
    STEP(pB0,pB1,pA0,pA1,t,true,true,true);     WAIT_BAR(2); RESC(); ROT();
    STEP(pA0,pA1,pB0,pB1,t+1,true,true,true);   WAIT_BAR(2); RESC(); ROT();
  }
  #undef CMASK
  #define CMASK(P0,P1,t) do{int jb_=(t)-(NT-4); if(jb_>=0)cmask(P0,P1,jb_,qrel,hi);}while(0)
  #define ENDW(tt) do{ if((tt)+3<NT){WAIT_BAR(2);} else if((tt)+2<NT){WAIT_BAR(1);} else {WAIT_BAR(0);} }while(0)
  for(;t+1<NT;t+=2){
    STEP(pB0,pB1,pA0,pA1,t,(t+3<NT),(t+1<NT),(t+1<NT));       ENDW(t);   RESC(); ROT();
    STEP(pA0,pA1,pB0,pB1,t+1,(t+4<NT),(t+2<NT),(t+2<NT));     ENDW(t+1); RESC(); ROT();
  }
  STEP(pB0,pB1,pA0,pA1,NT-1,false,false,false); RESC();
  { float sacc=pB0[0]+pB0[1]; _Pragma("unroll") for(int r=2;r<16;++r)sacc+=pB0[r]; _Pragma("unroll") for(int r=0;r<16;++r)sacc+=pB1[r]; l_reg+=sacc;
    pw0=(u32x4){PKW(pB0,0),PKW(pB0,2),PKW(pB0,4),PKW(pB0,6)};pw1=(u32x4){PKW(pB0,8),PKW(pB0,10),PKW(pB0,12),PKW(pB0,14)};pw2=(u32x4){PKW(pB1,0),PKW(pB1,2),PKW(pB1,4),PKW(pB1,6)};pw3=(u32x4){PKW(pB1,8),PKW(pB1,10),PKW(pB1,12),PKW(pB1,14)};
    SBAR(); pv(o,vb0+sl_cur,PAF(0),PAF(1),PAF(2),PAF(3)); }
  #undef PKW
  #undef PAF
  #undef VFR
  #undef PIN
  #undef MX3
  #undef GAPA
  #undef GAPB
  #undef EX
  #undef VRD
  #undef KRD
  #undef STEP
  #undef ENDW
  {auto rr=__builtin_amdgcn_permlane32_swap(__float_as_uint(l_reg),__float_as_uint(l_reg),false,false);l_reg=__uint_as_float(rr[0])+__uint_as_float(rr[1]);}
  if(hi==0)wsf[32+r32]=l_reg;asm volatile("s_waitcnt lgkmcnt(0)":::"memory");
  float rli[16];
  #pragma unroll
  for(int r=0;r<16;++r)rli[r]=__builtin_amdgcn_rcpf(wsf[32+crow(r,hi)]);
  bf16*Ow=Oh+(long)(q0+wid*QBLK)*PO;
  { bf16*stg=(bf16*)(shm+LDS_OST)+wid*2048;
    #pragma unroll
    for(int r=0;r<16;++r){const int orow=crow(r,hi);
      #pragma unroll
      for(int d0=0;d0<2;++d0)stg[orow*64+d0*32+r32]=__float2bfloat16(o[d0][r]*rli[r]);}
    asm volatile("s_waitcnt lgkmcnt(0)":::"memory");
    #pragma unroll
    for(int i=0;i<4;++i){const int row=i*8+(lane>>3),ch=lane&7; const u32x4 v=*(const u32x4*)(stg+row*64+ch*8); ATTN_STORE16(Ow+(long)row*PO+ch*8,v);} }
  asm volatile("s_waitcnt lgkmcnt(0)\n\ts_barrier":::"memory");
  #undef DMA_K
  #undef DMA_V
  #undef CMASK
  #undef SETBIAS
  #undef START
  #undef RESC
  #undef ROT
}

constexpr int DV_LDS_WS=LDS_V+NSLOT*2*SLOTB, DV_LDS_OST=DV_LDS_WS+NW*64*4, DV_LDS_BYTES=DV_LDS_OST+NW*4096;
__device__ __forceinline__ void attn_unit_dv(int qb,const bf16*Qh,const bf16*__restrict__ Kh,const bf16*__restrict__ Vh,bf16*Oh,char*shm){
  int tid_=threadIdx.x; asm volatile("":"+v"(tid_)); const int tid=tid_,lane=tid&63,r32=lane&31,hi=lane>>5; const int wid=__builtin_amdgcn_readfirstlane(tid>>6);
  const int q0=qb*QB;
  const bf16*Qw=Qh+(long)(q0+wid*QBLK)*PQ;
  const unsigned lds0=(unsigned)(uintptr_t)shm;
  float*wsf=(float*)(shm+DV_LDS_WS)+wid*64;
  const bf16*ksrc=Kh+(long)lane*PQ+wid*8;
  const bf16*vsrc=Vh+(long)(16*(wid&3)+(lane>>2))*PQ+(wid>>2)*32+(lane&3)*8;
  const unsigned kdst=lds0+LDS_K+wid*1024, vdst=lds0+LDS_V+wid*1024;
  #define DMA_K(t,slot) glds16(ksrc+(long)(t)*KVBLK*PQ,(unsigned)__builtin_amdgcn_readfirstlane(kdst+(slot)))
  #define DMA_V(t,slot) do{ glds16(vsrc+(long)(t)*KVBLK*PQ,(unsigned)__builtin_amdgcn_readfirstlane(vdst+2*(slot))); glds16(vsrc+(long)SEQ*64+(long)(t)*KVBLK*PQ,(unsigned)__builtin_amdgcn_readfirstlane(vdst+2*(slot)+8192)); }while(0)
  const int vb0=(int)(lds0+LDS_V)+((lane>>4)&1)*32+(lane&3)*8+(4*hi+((lane&15)>>2))*64;
  const char*Kbase=shm+LDS_K; bf16x8 kf[8];
  const lds_cptr shm3=(lds_cptr)shm; const lds_cptr kp0=shm3+LDS_K+hi*1024+r32*16; const lds_cptr vp0=shm3+LDS_V+((lane>>4)&1)*32+(lane&3)*8+(4*hi+((lane&15)>>2))*64;
  const int NT=(q0+QB)/KVBLK;
  if(wid>=4)__builtin_amdgcn_s_setprio(1);
  DMA_K(0,0);DMA_V(0,0);DMA_K(1,SLOTB);
  bf16x8 qr[4];
  #pragma unroll
  for(int d0=0;d0<4;++d0)qr[d0]=*reinterpret_cast<const bf16x8*>(&Qw[(long)r32*PQ+d0*16+hi*8]);
  float l_reg=0.f;f32x16 o[4];o[0]=f32x16{};o[1]=f32x16{};o[2]=f32x16{};o[3]=f32x16{};const f32x16 z16=f32x16{};
  const int qrel=wid*QBLK+r32;
  #define CMASK(P0,P1,t) do{int jb_=(t)-(NT-4); if(jb_>=0)cmask(P0,P1,jb_,qrel,hi);}while(0)
  f32x16 pA0,pA1;
  int sl_prev=0,sl_cur=0,sl_next=SLOTB;
  #define ROT() do{sl_prev=sl_cur;sl_cur=sl_next;sl_next=(sl_next==(NSLOT-1)*SLOTB)?0:sl_next+SLOTB;}while(0)
  u32x4 pw0,pw1,pw2,pw3;
  #define PKW(P,B) cvtpk_s(P[B],P[B+1])
  #define PAF(k) __builtin_bit_cast(bf16x8,pw##k)
  #define PIN(x) asm volatile("":"+v"(x))
  #define EX(v) __builtin_amdgcn_exp2f(v)
  #define PACKP(P0,P1) do{ float sa_=(P0[0]+P0[1])+(P0[2]+P0[3]), sb_=(P1[0]+P1[1])+(P1[2]+P1[3]); \
    _Pragma("unroll") for(int r_=4;r_<16;r_+=4){ sa_+=(P0[r_]+P0[r_+1])+(P0[r_+2]+P0[r_+3]); sb_+=(P1[r_]+P1[r_+1])+(P1[r_+2]+P1[r_+3]); } l_reg+=sa_+sb_; \
    pw0=(u32x4){PKW(P0,0),PKW(P0,2),PKW(P0,4),PKW(P0,6)};pw1=(u32x4){PKW(P0,8),PKW(P0,10),PKW(P0,12),PKW(P0,14)};pw2=(u32x4){PKW(P1,0),PKW(P1,2),PKW(P1,4),PKW(P1,6)};pw3=(u32x4){PKW(P1,8),PKW(P1,10),PKW(P1,12),PKW(P1,14)}; PIN(pw0);PIN(pw1);PIN(pw2);PIN(pw3);PIN(l_reg); }while(0)
  DMA_K(2,2*SLOTB);
  WAIT_BAR(3);
  qkt(pA0,pA1,Kbase,qr,z16,r32,hi);CMASK(pA0,pA1,0);
  _Pragma("unroll") for(int r=0;r<16;++r){pA0[r]=EX(pA0[r]);pA1[r]=EX(pA1[r]);}
  PACKP(pA0,pA1);
  WAIT_BAR(0);
  DMA_K(3,0);DMA_V(1,SLOTB);
  ROT();
  kload8(kf,kp0+sl_cur);
  WAIT_BAR(3);
  s16x4 valo[2][4],vahi[2][4];
  #define VLD1(buf,ks,db) do{ valo[buf][db]=vtr(vp_+((db)*4096+(ks)*1024)); vahi[buf][db]=vtr(vp_+((db)*4096+(ks)*1024+512)); }while(0)
  #define VF(buf,db) (bf16x8){valo[buf][db][0],valo[buf][db][1],valo[buf][db][2],valo[buf][db][3],vahi[buf][db][0],vahi[buf][db][1],vahi[buf][db][2],vahi[buf][db][3]}
  #define KRD(G,j) do{ if(G){ kload2(kf,kp0+sl_next,j); SBAR(); } }while(0)
  #define QK(C,kk,qq,Cin) do{ C=__builtin_amdgcn_mfma_f32_32x32x16_bf16(kf[kk],qr[qq],Cin,0,0,0); SBAR(); }while(0)
  #define MFO(db,ks,buf) o[db]=__builtin_amdgcn_mfma_f32_32x32x16_bf16(PAF(ks),VF(buf,db),o[db],0,0,0)
  #define G4(ks,buf,X,B,DOPREV,PX,PB,PWP) do{ \
    MFO(0,ks,buf); X[B]=EX(X[B]); X[B+1]=EX(X[B+1]); if(DOPREV){ sacc+=PX[PB]; sacc+=PX[PB+1]; PWP[0]=PKW(PX,PB); } PIN(X); SBAR(); \
    MFO(1,ks,buf); X[B+2]=EX(X[B+2]); X[B+3]=EX(X[B+3]); if(DOPREV){ sacc+=PX[PB+2]; sacc+=PX[PB+3]; PWP[1]=PKW(PX,PB+2); } PIN(X); SBAR(); \
    MFO(2,ks,buf); X[B+4]=EX(X[B+4]); X[B+5]=EX(X[B+5]); if(DOPREV){ sacc+=PX[PB+4]; sacc+=PX[PB+5]; PWP[2]=PKW(PX,PB+4); } PIN(X); SBAR(); \
    MFO(3,ks,buf); X[B+6]=EX(X[B+6]); X[B+7]=EX(X[B+7]); if(DOPREV){ sacc+=PX[PB+6]; sacc+=PX[PB+7]; PWP[3]=PKW(PX,PB+6); PIN(PWP); } PIN(X); PIN(sacc); SBAR(); \
    }while(0)
  #define STEP(C0,C1,t,GK,GV,GL) do{ SBAR(); \
    const lds_cptr vp_=vp0+2*sl_prev; float sacc=0.f; \
    VLD1(0,0,0); SBAR(); QK(C0,0,0,z16); \
    VLD1(0,0,1); SBAR(); QK(C1,1,0,z16); \
    VLD1(0,0,2); SBAR(); QK(C0,2,1,C0); \
    VLD1(0,0,3); SBAR(); QK(C1,3,1,C1); \
    VLD1(1,1,0); SBAR(); QK(C0,4,2,C0); \
    VLD1(1,1,1); SBAR(); QK(C1,5,2,C1); \
    VLD1(1,1,2); SBAR(); QK(C0,6,3,C0); \
    VLD1(1,1,3); SBAR(); QK(C1,7,3,C1); \
    if(GK){DMA_K((t)+3,sl_cur);} if(GV){DMA_V((t)+1,sl_next);} \
    CMASK(C0,C1,t); \
    SBAR(); \
    G4(0,0,C0,0,false,C0,0,pw0); \
    VLD1(0,2,0); VLD1(0,2,1); VLD1(0,2,2); VLD1(0,2,3); SBAR(); KRD(GL,0); KRD(GL,1); \
    G4(1,1,C0,8,true,C0,0,pw0); \
    VLD1(1,3,0); VLD1(1,3,1); VLD1(1,3,2); VLD1(1,3,3); SBAR(); KRD(GL,2); KRD(GL,3); \
    G4(2,0,C1,0,true,C0,8,pw1); \
    G4(3,1,C1,8,true,C1,0,pw2); \
    sacc+=(C1[8]+C1[9])+(C1[10]+C1[11]); sacc+=(C1[12]+C1[13])+(C1[14]+C1[15]); l_reg+=sacc; \
    pw3=(u32x4){PKW(C1,8),PKW(C1,10),PKW(C1,12),PKW(C1,14)}; PIN(pw3); PIN(l_reg); PIN(o[0]);PIN(o[1]);PIN(o[2]);PIN(o[3]); SBAR(); \
    }while(0)
  int t=1;
  #undef CMASK
  #define CMASK(P0,P1,t) do{}while(0)
  for(;t+5<NT;t+=2){
    STEP(pA0,pA1,t,true,true,true);     WAIT_BAR(3); ROT();
    STEP(pA0,pA1,t+1,true,true,true);   WAIT_BAR(3); ROT();
  }
  #undef CMASK
  #define CMASK(P0,P1,t) do{int jb_=(t)-(NT-4); if(jb_>=0)cmask(P0,P1,jb_,qrel,hi);}while(0)
  #define ENDW(tt) do{ if((tt)+3<NT){WAIT_BAR(3);} else if((tt)+2<NT){WAIT_BAR(2);} else {WAIT_BAR(0);} }while(0)
  for(;t+1<NT;t+=2){
    STEP(pA0,pA1,t,(t+3<NT),(t+1<NT),(t+1<NT));       ENDW(t);   ROT();
    STEP(pA0,pA1,t+1,(t+4<NT),(t+2<NT),(t+2<NT));     ENDW(t+1); ROT();
  }
  STEP(pA0,pA1,NT-1,false,false,false);
  SBAR(); pv2(o[0],o[1],vb0+2*sl_cur,PAF(0),PAF(1),PAF(2),PAF(3)); pv2(o[2],o[3],vb0+2*sl_cur+8192,PAF(0),PAF(1),PAF(2),PAF(3));
  #undef PKW
  #undef PAF
  #undef PIN
  #undef EX
  #undef VLD1
  #undef VF
  #undef MFO
  #undef G4
  #undef KRD
  #undef QK
  #undef STEP
  #undef ENDW
  #undef PACKP
  {auto rr=__builtin_amdgcn_permlane32_swap(__float_as_uint(l_reg),__float_as_uint(l_reg),false,false);l_reg=__uint_as_float(rr[0])+__uint_as_float(rr[1]);}
  if(hi==0)wsf[32+r32]=l_reg;asm volatile("s_waitcnt lgkmcnt(0)":::"memory");
  float rli[16];
  #pragma unroll
  for(int r=0;r<16;++r)rli[r]=__builtin_amdgcn_rcpf(wsf[32+crow(r,hi)]);
  bf16*Ow=Oh+(long)(q0+wid*QBLK)*PO;
  { bf16*stg=(bf16*)(shm+DV_LDS_OST)+wid*2048;
    #pragma unroll
    for(int hh=0;hh<2;++hh){
      #pragma unroll
      for(int r=0;r<16;++r){const int orow=crow(r,hi);
        #pragma unroll
        for(int d0=0;d0<2;++d0)stg[orow*64+d0*32+r32]=__float2bfloat16(o[2*hh+d0][r]*rli[r]);}
      asm volatile("s_waitcnt lgkmcnt(0)":::"memory");
      #pragma unroll
      for(int i=0;i<4;++i){const int row=i*8+(lane>>3),ch=lane&7; const u32x4 v=*(const u32x4*)(stg+row*64+ch*8); ATTN_STORE16(Ow+(long)row*PO+hh*64+ch*8,v);}
      asm volatile("s_waitcnt lgkmcnt(0)":::"memory"); } }
  __builtin_amdgcn_s_setprio(0);
  asm volatile("s_waitcnt lgkmcnt(0)\n\ts_barrier":::"memory");
  #undef DMA_K
  #undef DMA_V
  #undef CMASK
  #undef ROT
}

__device__ __forceinline__ void pv2c(f32x16&oa,f32x16&ob,lds_cptr vb,bf16x8 pa0,bf16x8 pa1,bf16x8 pa2,bf16x8 pa3){
  #pragma unroll
  for(int d0=0;d0<2;++d0){ s16x4 lo[4],hi[4];
    #pragma unroll
    for(int ks=0;ks<4;++ks){ lo[ks]=vtr(vb+(d0*4096+ks*1024)); hi[ks]=vtr(vb+(d0*4096+ks*1024+512)); }
    #define PK(k) (bf16x8){lo[k][0],lo[k][1],lo[k][2],lo[k][3],hi[k][0],hi[k][1],hi[k][2],hi[k][3]}
    f32x16 acc=d0?ob:oa;
    acc=__builtin_amdgcn_mfma_f32_32x32x16_bf16(pa0,PK(0),acc,0,0,0);
    acc=__builtin_amdgcn_mfma_f32_32x32x16_bf16(pa1,PK(1),acc,0,0,0);
    acc=__builtin_amdgcn_mfma_f32_32x32x16_bf16(pa2,PK(2),acc,0,0,0);
    acc=__builtin_amdgcn_mfma_f32_32x32x16_bf16(pa3,PK(3),acc,0,0,0);
    if(d0)ob=acc;else oa=acc;
    #undef PK
  }
}
constexpr int MB_K=0, MB_V=32768, MB_WS=65536, MB_OST=MB_WS+NW*256, MB_END=MB_OST+NW*4096;
__device__ __forceinline__ void moba_load_block(const bf16*Kb,const bf16*Vb,char*shm){
  int tid_=threadIdx.x; asm volatile("":"+v"(tid_)); const int lane=tid_&63; const int wid=__builtin_amdgcn_readfirstlane(tid_>>6);
  const unsigned lds0=(unsigned)(uintptr_t)shm;
  const bf16*ksrc=Kb+(long)lane*PQ+wid*8;
  const bf16*vsrc=Vb+(long)(16*(wid&3)+(lane>>2))*PQ+(wid>>2)*32+(lane&3)*8;
  #pragma unroll
  for(int t=0;t<4;++t){ glds16(ksrc+(long)t*KVBLK*PQ,(unsigned)__builtin_amdgcn_readfirstlane(lds0+MB_K+t*8192+wid*1024)); glds16(vsrc+(long)t*KVBLK*PQ,(unsigned)__builtin_amdgcn_readfirstlane(lds0+MB_V+t*8192+wid*1024)); }
  asm volatile("s_waitcnt vmcnt(0) lgkmcnt(0)\n\ts_barrier":::"memory");
}
struct MobaQ { bf16x8 f[4]; };
__device__ __forceinline__ MobaQ moba_qload(const bf16*Qh,int q){ int tid_=threadIdx.x; asm volatile("":"+v"(tid_)); const int hi=(tid_&63)>>5; MobaQ r;
  #pragma unroll
  for(int d0=0;d0<4;++d0)r.f[d0]=*reinterpret_cast<const bf16x8*>(&Qh[(long)q*PQ+d0*16+hi*8]); return r; }
template<bool CAUSAL> __device__ __forceinline__ void moba_task(const MobaQ&Q,int qrel,char*shm){
  int tid_=threadIdx.x; asm volatile("":"+v"(tid_)); const int lane=tid_&63,r32=lane&31,hi=lane>>5; const int wid=__builtin_amdgcn_readfirstlane(tid_>>6);
  const unsigned lds0=(unsigned)(uintptr_t)shm;
  float*wsf=(float*)(shm+MB_WS)+wid*64;
  const lds_cptr vb0=(lds_cptr)shm+MB_V+((lane>>4)&1)*32+(lane&3)*8+(4*hi+((lane&15)>>2))*64;
  f32x16 o[2];o[0]=f32x16{};o[1]=f32x16{};float l_reg=0.f;const f32x16 z16=f32x16{};
  #pragma unroll
  for(int t=0;t<4;++t){
    const int wrow0=__builtin_amdgcn_readfirstlane(qrel)&~31;
    if(CAUSAL&&t*64>wrow0+31)continue;
    f32x16 p0,p1;
    qkt(p0,p1,shm+MB_K+t*8192,Q.f,z16,r32,hi);
    if(CAUSAL&&t*64+63>wrow0)cmask(p0,p1,t,qrel,hi);
    #pragma unroll
    for(int r=0;r<16;++r){p0[r]=__builtin_amdgcn_exp2f(p0[r]);p1[r]=__builtin_amdgcn_exp2f(p1[r]);}
    float sa=(p0[0]+p0[1])+(p0[2]+p0[3]),sb=(p1[0]+p1[1])+(p1[2]+p1[3]);
    #pragma unroll
    for(int r=4;r<16;r+=4){sa+=(p0[r]+p0[r+1])+(p0[r+2]+p0[r+3]);sb+=(p1[r]+p1[r+1])+(p1[r+2]+p1[r+3]);}
    l_reg+=sa+sb;
    const u32x4 w0={cvtpk_s(p0[0],p0[1]),cvtpk_s(p0[2],p0[3]),cvtpk_s(p0[4],p0[5]),cvtpk_s(p0[6],p0[7])},w1={cvtpk_s(p0[8],p0[9]),cvtpk_s(p0[10],p0[11]),cvtpk_s(p0[12],p0[13]),cvtpk_s(p0[14],p0[15])};
    const u32x4 w2={cvtpk_s(p1[0],p1[1]),cvtpk_s(p1[2],p1[3]),cvtpk_s(p1[4],p1[5]),cvtpk_s(p1[6],p1[7])},w3={cvtpk_s(p1[8],p1[9]),cvtpk_s(p1[10],p1[11]),cvtpk_s(p1[12],p1[13]),cvtpk_s(p1[14],p1[15])};
    pv2c(o[0],o[1],vb0+t*8192,__builtin_bit_cast(bf16x8,w0),__builtin_bit_cast(bf16x8,w1),__builtin_bit_cast(bf16x8,w2),__builtin_bit_cast(bf16x8,w3));
  }
  {auto rr=__builtin_amdgcn_permlane32_swap(__float_as_uint(l_reg),__float_as_uint(l_reg),false,false);l_reg=__uint_as_float(rr[0])+__uint_as_float(rr[1]);}
  if(hi==0)wsf[32+r32]=l_reg;asm volatile("s_waitcnt lgkmcnt(0)":::"memory");
  float rli[16];
  #pragma unroll
  for(int r=0;r<16;++r)rli[r]=__builtin_amdgcn_rcpf(wsf[32+crow(r,hi)]);
  bf16*stg=(bf16*)(shm+MB_OST)+wid*2048;
  #pragma unroll
  for(int r=0;r<16;++r){const int orow=crow(r,hi);
    #pragma unroll
    for(int d0=0;d0<2;++d0)stg[orow*64+d0*32+r32]=__float2bfloat16(o[d0][r]*rli[r]);}
  asm volatile("s_waitcnt lgkmcnt(0)":::"memory");
}
constexpr int ATTN_LDS_BYTES=LDS_BYTES;
#undef SBAR
#undef WAIT_BAR
}
#include <hip/hip_cooperative_groups.h>
namespace cg = cooperative_groups;
constexpr int NWAVES = 8;
constexpr int BATCH = 4, SEQ = 8192, DM = 1024, M = BATCH * SEQ, NPROJ = 3072, FFN = 2816, NGU = 2 * FFN;
constexpr size_t MiB = 1u << 20;
constexpr size_t WS_WIN = 0, WS_WOUT = 6 * MiB, WS_WGU = 8 * MiB, WS_WDN = 19 * MiB;
constexpr size_t WS_ROPE = 25 * MiB;
constexpr size_t WS_KMEAN = 27 * MiB;
constexpr size_t WS_GTAB = 27 * MiB + 512 * 1024;
constexpr size_t WS_BAR = 31 * MiB;
constexpr size_t WS_SS = 28 * MiB;
constexpr size_t WS_XN = 32 * MiB;
constexpr size_t WS_QKV = 96 * MiB;
constexpr size_t WS_OST = 288 * MiB;
constexpr size_t WS_MIX = 352 * MiB;
constexpr size_t WS_GL = 32 * MiB;
constexpr size_t WS_GC = 48 * MiB;
constexpr size_t WS_LP = 49 * MiB;
constexpr size_t WS_OP = 416 * MiB;
constexpr size_t WS_END = 512 * MiB;
constexpr int RING_BYTES = 131072, KM_OFF = 86016, LDS_BYTES = 147456;
#define GAS __attribute__((address_space(1)))
#define LAS __attribute__((address_space(3)))
typedef unsigned short bf16;
typedef unsigned v4u __attribute__((ext_vector_type(4)));
typedef float f32x4 __attribute__((ext_vector_type(4)));
#define LDS_WAIT() asm volatile("s_waitcnt lgkmcnt(0)" ::: "memory")
#define XB_TMO      128
#define XB_XCNT(j)  (256  + 64 * (j))
#define XB_XSUB(j)  (1280 + 64 * (j))
#define XB_XGEN(j)  (2304 + 64 * (j))
#define XB_TOP      3328
#define XB_TOPGEN   3392
#define XCD_BAR_WORDS 3456
#define XB_SPIN_CAP (1u << 18)

__device__ __forceinline__ unsigned xb_ld(unsigned* p)              { return __hip_atomic_load(p, __ATOMIC_RELAXED, __HIP_MEMORY_SCOPE_AGENT); }
__device__ __forceinline__ unsigned xb_add(unsigned* p, unsigned v) { return __hip_atomic_fetch_add(p, v, __ATOMIC_RELAXED, __HIP_MEMORY_SCOPE_AGENT); }
__device__ __forceinline__ unsigned xb_xcc_id() { return (unsigned)__builtin_amdgcn_s_getreg((3 << 11) | 20) & 0xFu; }
#define XB_SPIN(cond, bar) do { unsigned _sp = 0; while (cond) { __builtin_amdgcn_s_sleep(1); \
    if ((++_sp & 255u) == 0u) { if (xb_ld(&(bar)[XB_TMO])) break; if (_sp > XB_SPIN_CAP) { atomicAdd(&(bar)[XB_TMO], 1u); break; } } } } while (0)

struct XcdBarrier {
    unsigned* bar; unsigned x;
    volatile LAS unsigned* st;
};

__device__ __forceinline__ XcdBarrier xcd_barrier_post(unsigned* bar, volatile LAS unsigned* st) {
    XcdBarrier b; b.bar = bar; b.x = xb_xcc_id(); b.st = st;
    if (threadIdx.x == 0) (void)xb_add(&bar[XB_XCNT(b.x)], 1u);
    return b;
}
__device__ __forceinline__ void xcd_barrier_complete(unsigned* bar, unsigned x, unsigned& nloc, unsigned& nx) {
    const unsigned G = gridDim.x * gridDim.y * gridDim.z;
    unsigned sum, cnt, mine, sp = 0u;
    for (;;) {
        sum = 0u; cnt = 0u; mine = 0u;
#pragma unroll
        for (unsigned j = 0; j < 16; ++j) { const unsigned c = xb_ld(&bar[XB_XCNT(j)]); sum += c; cnt += (c > 0u) ? 1u : 0u; mine = (j == x) ? c : mine; }
        if (sum == G) break;
        __builtin_amdgcn_s_sleep(1);
        if ((++sp & 255u) == 0u) { if (xb_ld(&bar[XB_TMO])) break; if (sp > XB_SPIN_CAP) { atomicAdd(&bar[XB_TMO], 1u); break; } }
    }
    nloc = mine > 0u ? mine : 1u; nx = cnt > 0u ? cnt : 1u;
}

__device__ __forceinline__ void xcd_barrier(const XcdBarrier& b) {
    asm volatile("s_waitcnt vmcnt(0)" ::: "memory");
    __syncthreads();
    if (threadIdx.x == 0) {
        unsigned* bar = b.bar;
        __builtin_amdgcn_s_waitcnt(0);
        unsigned nloc = b.st[0], nx = b.st[1];
        if (nloc == 0u) { xcd_barrier_complete(bar, b.x, nloc, nx); b.st[0] = nloc; b.st[1] = nx; }
        const unsigned old = xb_add(&bar[XB_XSUB(b.x)], 1u);
        const unsigned gen = old / nloc;
        if (old + 1u == (gen + 1u) * nloc) {
            __builtin_amdgcn_fence(__ATOMIC_RELEASE, "agent");
            asm volatile("s_waitcnt vmcnt(0)" ::: "memory");
            const unsigned og = xb_add(&bar[XB_TOP], 1u);
            const unsigned tg = og / nx;
            if (og + 1u == (tg + 1u) * nx) xb_add(&bar[XB_TOPGEN], 1u);
            else XB_SPIN(xb_ld(&bar[XB_TOPGEN]) == tg, bar);
            __builtin_amdgcn_fence(__ATOMIC_ACQUIRE, "agent");
            xb_add(&bar[XB_XGEN(b.x)], 1u);
            asm volatile("s_waitcnt vmcnt(0)" ::: "memory");
        } else {
            XB_SPIN(xb_ld(&bar[XB_XGEN(b.x)]) == gen, bar);
            __builtin_amdgcn_fence(__ATOMIC_ACQUIRE, "agent");
            asm volatile("s_waitcnt vmcnt(0)" ::: "memory");
        }
    }
    __syncthreads();
}

__device__ __forceinline__ unsigned f2bf(float f) { unsigned u = __builtin_bit_cast(unsigned, f); return (u + 0x7fffu + ((u >> 16) & 1u)) >> 16; }
__device__ __forceinline__ unsigned pk2(float lo, float hi) { return f2bf(lo) | (f2bf(hi) << 16); }
__device__ __forceinline__ float bf_lo(unsigned w) { return __builtin_bit_cast(float, w << 16); }
__device__ __forceinline__ float bf_hi(unsigned w) { return __builtin_bit_cast(float, w & 0xffff0000u); }
__device__ __forceinline__ float wave_sum(float v) {
#pragma unroll
    for (int o = 1; o < 64; o <<= 1) v += __shfl_xor(v, o);
    return v;
}
__constant__ double ROPE_REV[32] = {
0.15915494309189535,
0.11934937021124886,
0.08949940160889101,
0.06711508300522726,
0.050329212104487035,
0.03774158471741977,
0.0283021958306234,
0.02122365276477766,
0.015915494309189534,
0.011934937021124886,
0.008949940160889102,
0.006711508300522725,
0.005032921210448704,
0.003774158471741977,
0.00283021958306234,
0.0021223652764777662,
0.0015915494309189536,
0.0011934937021124885,
0.0008949940160889102,
0.0006711508300522726,
0.0005032921210448703,
0.00037741584717419774,
0.00028302195830623395,
0.0002122365276477766,
0.00015915494309189535,
0.00011934937021124886,
8.949940160889102e-05,
6.711508300522725e-05,
5.0329212104487035e-05,
3.774158471741978e-05,
2.8302195830623396e-05,
2.122365276477766e-05
};
__device__ __forceinline__ void p0_transpose_item(const float* W, int K, int N, bf16* WT, int mode, const float* gain, LAS float* scr, int item, int lane) {
    const int nblk = N / 32, kb = item / nblk, nb = item % nblk, k0 = 64 * kb, n0 = 32 * nb;
    int dst;
    if (mode == 0) dst = n0;
    else if (mode == 1) { const int pn = n0 >> 8, r = n0 & 255; dst = pn * 256 + ((r >> 5) & 1) * 128 + (r >> 6) * 32; }
    else { const int pn = n0 >> 7, q0 = n0 & 127; dst = pn * 256 + (mode == 3 ? 128 : 0) + q0; }
    float wv[32];
#pragma unroll
    for (int i = 0; i < 32; ++i) { const int kk = 2 * i + (lane >> 5); wv[i] = __builtin_nontemporal_load(W + (size_t)(k0 + kk) * N + n0 + (lane & 31)); }
#pragma unroll
    for (int i = 0; i < 32; ++i) { const int kk = 2 * i + (lane >> 5); float w = wv[i]; if (gain) w *= gain[k0 + kk]; scr[kk * 33 + (lane & 31)] = w; }
    LDS_WAIT(); asm volatile("" ::: "memory");
    const int c = lane & 7;
#pragma unroll
    for (int j = 0; j < 4; ++j) { const int n = (lane >> 3) + 8 * j; const LAS float* s = scr + (8 * c) * 33 + n;
        v4u o; o.x = pk2(s[0 * 33], s[1 * 33]); o.y = pk2(s[2 * 33], s[3 * 33]); o.z = pk2(s[4 * 33], s[5 * 33]); o.w = pk2(s[6 * 33], s[7 * 33]);
        *(GAS v4u*)(WT + (size_t)(dst + n) * K + k0 + 8 * c) = o; }
    LDS_WAIT(); asm volatile("" ::: "memory");
}
#ifndef REP_G1
#define REP_G1 1
#endif
#ifndef REP_X
#define REP_X 1
#endif
#ifndef REP_Y
#define REP_Y 1
#endif
struct Args { const float* in[17]; float* out; unsigned char* ws; };
enum { I_X = 0, I_ATTN_NORM, I_W_IN, I_MQN, I_MKN, I_DQN, I_DKN, I_LQ1, I_LK1, I_LQ2, I_LK2, I_SUBLN, I_W_OUT, I_FFN_NORM, I_W_GATE, I_W_UP, I_W_DOWN };

__global__ void __launch_bounds__(NWAVES * 64, 2) hymba_fwd(Args args) {
    extern __shared__ __attribute__((aligned(16))) unsigned char lds[];
    cg::grid_group grid = cg::this_grid();
    volatile __attribute__((address_space(3))) unsigned* const xb_st = (volatile __attribute__((address_space(3))) unsigned*)((__attribute__((address_space(3))) unsigned char*)lds + 131072 + 64);
    if (threadIdx.x < 2) xb_st[threadIdx.x] = 0u;
    __syncthreads();
    const XcdBarrier xbar = xcd_barrier_post((unsigned*)(args.ws + WS_BAR), xb_st);
    LAS unsigned char* const ldsl = (LAS unsigned char*)lds;
    const int tid = threadIdx.x, lane = tid & 63, wave = __builtin_amdgcn_readfirstlane(tid >> 6);
    const int G = gridDim.x; const int bx = blockIdx.x;
    const int vcu = (G % 8 == 0) ? (bx % 8) * (G / 8) + bx / 8 : bx;
    unsigned char* const ws = args.ws;
    bf16* const Win_t = (bf16*)(ws + WS_WIN); bf16* const Wout_t = (bf16*)(ws + WS_WOUT); bf16* const Wgu_t = (bf16*)(ws + WS_WGU); bf16* const Wdn_t = (bf16*)(ws + WS_WDN);
    float* const rcos = (float*)(ws + WS_ROPE); float* const rsin = rcos + 8192 * 32;
    float* const gtab = (float*)(ws + WS_GTAB); float* const kmean = (float*)(ws + WS_KMEAN); float* const SS = (float*)(ws + WS_SS);
    bf16* const XN = (bf16*)(ws + WS_XN); bf16* const QKV = (bf16*)(ws + WS_QKV); bf16* const HB = (bf16*)(ws + WS_QKV);
    bf16* const OST = (bf16*)(ws + WS_OST); bf16* const MIX = (bf16*)(ws + WS_MIX);
    unsigned short* const GL = (unsigned short*)(ws + WS_GL); unsigned* const GC = (unsigned*)(ws + WS_GC); float* const LP = (float*)(ws + WS_LP); bf16* const OP = (bf16*)(ws + WS_OP);
    const float* const x = args.in[I_X]; float* const out = args.out;

    {
        LAS float* scr = (LAS float*)(ldsl + wave * 16384);
        const int gw = vcu * NWAVES + wave, NGW = G * NWAVES;
        constexpr int I_IN = (DM / 64) * (NPROJ / 32), I_OUT = (DM / 64) * (DM / 32), I_G = (DM / 64) * (FFN / 32), I_D = (FFN / 64) * (DM / 32);
        constexpr int NITEMS = I_IN + I_OUT + 2 * I_G + I_D;
        for (int it = gw; it < NITEMS; it += NGW) {
            int r = it;
            if (r < I_IN) { p0_transpose_item(args.in[I_W_IN], DM, NPROJ, Win_t, 1, nullptr, scr, r, lane); continue; } r -= I_IN;
            if (r < I_OUT) { p0_transpose_item(args.in[I_W_OUT], DM, DM, Wout_t, 0, nullptr, scr, r, lane); continue; } r -= I_OUT;
            if (r < I_G) { p0_transpose_item(args.in[I_W_GATE], DM, FFN, Wgu_t, 2, args.in[I_FFN_NORM], scr, r, lane); continue; } r -= I_G;
            if (r < I_G) { p0_transpose_item(args.in[I_W_UP], DM, FFN, Wgu_t, 3, args.in[I_FFN_NORM], scr, r, lane); continue; } r -= I_G;
            p0_transpose_item(args.in[I_W_DOWN], FFN, DM, Wdn_t, 0, nullptr, scr, r, lane);
        }
        const GAS f32x4* gp = (const GAS f32x4*)args.in[I_ATTN_NORM] + lane;
        f32x4 gn[4];
#pragma unroll
        for (int j = 0; j < 4; ++j) gn[j] = gp[64 * j];
        for (int m0 = gw; m0 < M; m0 += 2 * NGW) {
            const int m1 = (m0 + NGW < M) ? m0 + NGW : m0;
            const GAS f32x4* xr0 = (const GAS f32x4*)(x + (size_t)m0 * DM) + lane; const GAS f32x4* xr1 = (const GAS f32x4*)(x + (size_t)m1 * DM) + lane;
            f32x4 v0[4], v1[4]; float s0 = 0.f, s1 = 0.f;
#pragma unroll
            for (int j = 0; j < 4; ++j) { v0[j] = __builtin_nontemporal_load(xr0 + 64 * j); v1[j] = __builtin_nontemporal_load(xr1 + 64 * j); }
#pragma unroll
            for (int j = 0; j < 4; ++j) { s0 += (v0[j].x * v0[j].x + v0[j].y * v0[j].y) + (v0[j].z * v0[j].z + v0[j].w * v0[j].w); s1 += (v1[j].x * v1[j].x + v1[j].y * v1[j].y) + (v1[j].z * v1[j].z + v1[j].w * v1[j].w); }
#pragma unroll
            for (int o = 1; o < 64; o <<= 1) { s0 += __shfl_xor(s0, o); s1 += __shfl_xor(s1, o); }
            const float r0 = 1.0f / sqrtf(s0 * (1.f / DM) + 1e-6f), r1 = 1.0f / sqrtf(s1 * (1.f / DM) + 1e-6f);
            GAS unsigned long long* o0 = (GAS unsigned long long*)(XN + (size_t)m0 * DM) + lane; GAS unsigned long long* o1 = (GAS unsigned long long*)(XN + (size_t)m1 * DM) + lane;
#pragma unroll
            for (int j = 0; j < 4; ++j) { const f32x4 w0 = v0[j] * r0 * gn[j], w1 = v1[j] * r1 * gn[j];
                o0[64 * j] = (unsigned long long)pk2(w0.x, w0.y) | ((unsigned long long)pk2(w0.z, w0.w) << 32); o1[64 * j] = (unsigned long long)pk2(w1.x, w1.y) | ((unsigned long long)pk2(w1.z, w1.w) << 32); }
        }
        if (bx == 0) {
            if (tid < 64) gtab[tid] = args.in[I_MQN][tid];
            else if (tid < 128) gtab[tid] = args.in[I_MKN][tid - 64];
            else if (tid < 192) gtab[tid + 64] = args.in[I_DQN][tid - 128];
            else if (tid < 256) gtab[tid + 64] = args.in[I_DKN][tid - 192];
        }
        for (int e = bx * (NWAVES * 64) + tid; e < 8192 * 32; e += G * NWAVES * 64) {
            const int pos = e >> 5, i = e & 31;
            const double rev = (double)pos * ROPE_REV[i]; const float fr = (float)(rev - __builtin_rint(rev));
            rcos[e] = __builtin_amdgcn_cosf(fr); rsin[e] = __builtin_amdgcn_sinf(fr);
        }
    }
    if (gridDim.y == 0x7fffu) grid.sync();
    xcd_barrier(xbar);
    {
        pg8::Gemm g{XN, Win_t, M, NPROJ, DM}; pg8::StaticOrder S; S.init(M, NPROJ, G, bx);
        pg8::EpiQKV E{QKV, gtab, rcos, rsin, attn_body::C2, kmean};
        pg8::gemm_phase<pg8::EpiQKV, pg8::StaticOrder, PG8_ALIGN, PG8_SP2>(ldsl, g, S, E);
    }
    xcd_barrier(xbar);
    {
        const int r32 = lane & 31, hi = lane >> 5;
        for (int rep_ = 0; rep_ < REP_G1; ++rep_) {
#define G1_DECODE(U0, BH, QB) const int BH = (U0) >> 5, QB = (((U0) & 31) + 8 * ((U0) >> 8)) & 31
#define G1_LOADS(U0) do { if ((U0) < BATCH * 8 * 32) { G1_DECODE(U0, bh_, qb_); const float* kp_ = kmean + ((size_t)(bh_ * 32 + (tid >> 4)) * 2) * 64 + (tid & 15) * 4; pka = *(const GAS f32x4*)kp_; pkb = *(const GAS f32x4*)(kp_ + 64); \
            const bf16* qp_ = QKV + ((size_t)((bh_ >> 3) * 48 + (bh_ & 7)) * SEQ + qb_ * 256 + wave * 32 + r32) * 64 + hi * 8; _Pragma("unroll") for (int c_ = 0; c_ < 4; ++c_) pqw[c_] = *(const GAS v4u*)(qp_ + c_ * 16); } } while (0)
        f32x4 pka, pkb; v4u pqw[4];
        G1_LOADS(vcu);
        int par = 0, pbh = -1, pqb = 0;
        for (int u0 = vcu; u0 < BATCH * 8 * 32; u0 += G, par ^= 1) {
            G1_DECODE(u0, bh, qb); const int u = bh * 32 + qb;
            LAS unsigned char* kmh = ldsl + par * 16384; LAS unsigned char* kml = kmh + 8192;
            LAS unsigned* cnt = (LAS unsigned*)(ldsl + 32768 + par * 128); LAS unsigned* pcnt = (LAS unsigned*)(ldsl + 32768 + (par ^ 1) * 128);
            if (tid < 32) cnt[tid] = 0u;
            { const f32x4 m4 = (pka + pkb) * (1.0f / 256.0f);
              const int n_ = tid >> 4, d_ = (tid & 15) * 4; const unsigned off = (unsigned)((d_ >> 3) * 1024 + n_ * 16 + (d_ & 7) * 2);
              unsigned hw[4]; float lf[4];
#pragma unroll
              for (int e = 0; e < 4; ++e) { hw[e] = f2bf(m4[e]); lf[e] = m4[e] - __builtin_bit_cast(float, hw[e] << 16); }
              *(LAS unsigned long long*)(kmh + off) = (unsigned long long)(hw[0] | (hw[1] << 16)) | ((unsigned long long)(hw[2] | (hw[3] << 16)) << 32);
              *(LAS unsigned long long*)(kml + off) = (unsigned long long)pk2(lf[0], lf[1]) | ((unsigned long long)pk2(lf[2], lf[3]) << 32); }
            attn_body::bf16x8 qf[4];
#pragma unroll
            for (int c = 0; c < 4; ++c) qf[c] = __builtin_bit_cast(attn_body::bf16x8, pqw[c]);
            G1_LOADS(u0 + G);
            __syncthreads();
            if (pbh >= 0 && tid < 32) GC[(pbh * 32 + tid) * 32 + pqb] = pcnt[tid];
            pbh = bh; pqb = qb;
            attn_body::f32x16 gt = {};
#pragma unroll
            for (int d0 = 0; d0 < 4; ++d0) {
                const attn_body::bf16x8 kh_ = *(const LAS attn_body::bf16x8*)(kmh + hi * 1024 + r32 * 16 + d0 * 2048), kl_ = *(const LAS attn_body::bf16x8*)(kml + hi * 1024 + r32 * 16 + d0 * 2048);
                gt = __builtin_amdgcn_mfma_f32_32x32x16_bf16(kh_, qf[d0], gt, 0, 0, 0); gt = __builtin_amdgcn_mfma_f32_32x32x16_bf16(kl_, qf[d0], gt, 0, 0, 0); }
            float v1 = -INFINITY, v2 = -INFINITY, v3 = -INFINITY; int i1 = 0, i2 = 0, i3 = 0;
#pragma unroll
            for (int r = 0; r < 16; ++r) { const int n = (r & 3) + 8 * (r >> 2) + 4 * hi; const float p = n < qb ? gt[r] : -INFINITY;
                const bool g1 = p > v1, g2 = p > v2, g3 = p > v3;
                v3 = g2 ? v2 : (g3 ? p : v3); i3 = g2 ? i2 : (g3 ? n : i3);
                v2 = g1 ? v1 : (g2 ? p : v2); i2 = g1 ? i1 : (g2 ? n : i2);
                v1 = g1 ? p : v1; i1 = g1 ? n : i1; }
            { const float w1 = __shfl_xor(v1, 32), w2 = __shfl_xor(v2, 32), w3 = __shfl_xor(v3, 32); const int j1 = __shfl_xor(i1, 32), j2 = __shfl_xor(i2, 32), j3 = __shfl_xor(i3, 32);
#define G1_INS(P, N) do { const float p_ = (P); const int n_ = (N); const bool g1 = p_ > v1 || (p_ == v1 && n_ < i1), g2 = p_ > v2 || (p_ == v2 && n_ < i2), g3 = p_ > v3 || (p_ == v3 && n_ < i3); \
                v3 = g2 ? v2 : (g3 ? p_ : v3); i3 = g2 ? i2 : (g3 ? n_ : i3); v2 = g1 ? v1 : (g2 ? p_ : v2); i2 = g1 ? i1 : (g2 ? n_ : i2); v1 = g1 ? p_ : v1; i1 = g1 ? n_ : i1; } while (0)
              G1_INS(w1, j1); G1_INS(w2, j2); G1_INS(w3, j3);
#undef G1_INS
            }
            if (hi == 0) {
                const unsigned row = (unsigned)(wave * 32 + r32);
                if (qb >= 1) { const unsigned pos = __hip_atomic_fetch_add(cnt + i1, 1u, __ATOMIC_RELAXED, __HIP_MEMORY_SCOPE_WORKGROUP); GL[((size_t)u * 32 + i1) * 256 + pos] = (unsigned short)(row | (0u << 8)); }
                if (qb >= 2) { const unsigned pos = __hip_atomic_fetch_add(cnt + i2, 1u, __ATOMIC_RELAXED, __HIP_MEMORY_SCOPE_WORKGROUP); GL[((size_t)u * 32 + i2) * 256 + pos] = (unsigned short)(row | (1u << 8)); }
                if (qb >= 3) { const unsigned pos = __hip_atomic_fetch_add(cnt + i3, 1u, __ATOMIC_RELAXED, __HIP_MEMORY_SCOPE_WORKGROUP); GL[((size_t)u * 32 + i3) * 256 + pos] = (unsigned short)(row | (2u << 8)); }
            }
        }
        __syncthreads();
        if (pbh >= 0 && tid < 32) GC[(pbh * 32 + tid) * 32 + pqb] = ((LAS unsigned*)(ldsl + 32768 + (par ^ 1) * 128))[tid];
        __syncthreads();
        }
#undef G1_LOADS
#undef G1_DECODE
    }
    xcd_barrier(xbar);
    float lam;
    { float d1 = args.in[I_LQ1][lane] * args.in[I_LK1][lane], d2 = args.in[I_LQ2][lane] * args.in[I_LK2][lane];
      d1 = wave_sum(d1); d2 = wave_sum(d2);
      lam = __builtin_amdgcn_exp2f(d1 * 1.4426950408889634f) - __builtin_amdgcn_exp2f(d2 * 1.4426950408889634f) + 0.2f; }
#pragma unroll 1
    for (int ph = 0; ph < 2; ++ph) {
        const int r32 = lane & 31;
        LAS unsigned* gpre = (LAS unsigned*)(ldsl + 110592);
        LAS unsigned* nlist = (LAS unsigned*)(ldsl + 114688);
        LAS unsigned* pq = (LAS unsigned*)(ldsl + 118784);
        if (ph == 0) {
            for (int L = tid; L < 1024; L += NWAVES * 64) {
                unsigned n = 0;
                if (L < 992) { const int bh = L / 31, ix = L % 31, jj = (ix & 1) ? 30 - (ix >> 1) : (ix >> 1);     const v4u* cp = (const v4u*)(GC + (size_t)(bh * 32 + jj) * 32);
#pragma unroll
                    for (int c = 0; c < 8; ++c) { const v4u w = cp[c]; n += (w.x + w.y) + (w.z + w.w); }
                    nlist[L] = n; }
                gpre[L] = (n + 31u) >> 5;
            }
            __syncthreads();
            if (wave == 0) {
                unsigned c[16], sum = 0;
#pragma unroll
                for (int k = 0; k < 16; ++k) { c[k] = gpre[lane * 16 + k]; sum += c[k]; }
                unsigned incl = sum;
#pragma unroll
                for (int o = 1; o < 64; o <<= 1) { const unsigned t = __shfl_up(incl, o); if (lane >= o) incl += t; }
                unsigned run = incl - sum;
#pragma unroll
                for (int k = 0; k < 16; ++k) { gpre[lane * 16 + k] = run; run += c[k]; }
            }
            __syncthreads();
        }
        for (int v = vcu; v < 256; v += G) {
#pragma unroll 1
            for (int which = 0; which < 2; ++which) {
                const int bh = v >> 4, s = v & 15, b = bh >> 2, dh = bh & 3, mm = ph;
                const int qb = which ? 31 - s : s;
                const bf16* base = QKV + (size_t)b * 48 * SEQ * 64;
                attn_body::attn_unit_dv(qb, (const attn_body::bf16*)(base + (size_t)(24 + 2 * dh + mm) * SEQ * 64), (const attn_body::bf16*)(base + (size_t)(32 + 2 * dh + mm) * SEQ * 64),
                                        (const attn_body::bf16*)(base + (size_t)(40 + 2 * dh) * SEQ * 64), (attn_body::bf16*)(OST + (size_t)b * SEQ * DM + (2 * dh + mm) * 128), (char*)lds);
            }
            if (ph == 0) for (int rep_ = 0; rep_ < REP_X; ++rep_) {
                const unsigned T = gpre[992];
                unsigned lo = (unsigned)(((unsigned long long)T * (unsigned)v) >> 8), hiT = (unsigned)(((unsigned long long)T * (unsigned)(v + 1)) >> 8);
                int L = 0; { int a = 0, bnd = 992; while (bnd - a > 1) { const int mid = (a + bnd) >> 1; if (gpre[mid] <= lo) a = mid; else bnd = mid; } L = a; }
                const int L0 = L; LAS unsigned* const pqt = (LAS unsigned*)(ldsl + 118784 + 256);
                {
                    for (int li = wave; li < 16; li += NWAVES) { const int Lx = L0 + li;
                        if (Lx < 992) { const int bhx = Lx / 31, ixx = Lx % 31, jjx = (ixx & 1) ? 30 - (ixx >> 1) : (ixx >> 1);
                            const unsigned cq = (lane < 32) ? GC[(size_t)(bhx * 32 + jjx) * 32 + lane] : 0u; unsigned incl = cq;
#pragma unroll
                            for (int o = 1; o < 32; o <<= 1) { const unsigned t = __shfl_up(incl, o); if (lane >= o) incl += t; }
                            if (lane < 32) pqt[li * 33 + lane + 1] = incl; if (lane == 0) pqt[li * 33] = 0u; } }
                    __syncthreads();
                }
#pragma unroll 1
                while (lo < hiT) {
                    const unsigned g0 = gpre[L], g1 = gpre[L + 1];
                    if (g1 <= lo) { ++L; continue; }
                    const unsigned segE = (hiT < g1 ? hiT : g1);
                    const int bh = L / 31, ix = L % 31, jj = (ix & 1) ? 30 - (ix >> 1) : (ix >> 1); const unsigned n = nlist[L];
                    const bool pre = (L - L0) < 16; LAS unsigned* const pqs = pre ? pqt + (L - L0) * 33 : pq;
                    if (!pre && tid < 64) {
                        const unsigned cq = (lane < 32) ? GC[(size_t)(bh * 32 + jj) * 32 + lane] : 0u; unsigned incl = cq;
#pragma unroll
                        for (int o = 1; o < 32; o <<= 1) { const unsigned t = __shfl_up(incl, o); if (lane >= o) incl += t; }
                        if (lane < 32) pq[lane + 1] = incl; if (lane == 0) pq[0] = 0u;
                    }
                    const bf16* hb = QKV + (size_t)((bh >> 3) * 48 + (bh & 7)) * SEQ * 64;
                    if (!pre) __syncthreads();
                    const unsigned wend = segE - g0;
                    int lane_ = tid & 63; asm volatile("" : "+v"(lane_)); const int lane = lane_, r32 = lane & 31;
#define MB_RESOLVE(W, VALID, QBQ, ENT) do { const unsigned p_ = (W) * 32 + r32; VALID = ((W) < wend) && (p_ < n); int a_ = 0, bnd_ = 32; while (bnd_ - a_ > 1) { const int mid_ = (a_ + bnd_) >> 1; if (pqs[mid_] <= p_) a_ = mid_; else bnd_ = mid_; } QBQ = a_; \
                        ENT = 0; if (VALID) ENT = GL[((size_t)(bh * 32 + a_) * 32 + jj) * 256 + (p_ - pqs[a_])]; } while (0)
                    unsigned w = (lo - g0) + wave;
                    bool val0, val1, val2; int qq0, qq1, qq2; unsigned en0, en1, en2;
                    MB_RESOLVE(w, val0, qq0, en0); MB_RESOLVE(w + NWAVES, val1, qq1, en1);
                    attn_body::moba_load_block((const attn_body::bf16*)(hb + (size_t)8 * SEQ * 64 + (size_t)jj * 256 * 64), (const attn_body::bf16*)(hb + (size_t)16 * SEQ * 64 + (size_t)jj * 256 * 64), (char*)lds);
                    attn_body::MobaQ qa = attn_body::moba_qload((const attn_body::bf16*)hb, val0 ? qq0 * 256 + (int)(en0 & 255u) : 0);
#pragma unroll 1
                    for (; w < wend; w += NWAVES) {
                        MB_RESOLVE(w + 2 * NWAVES, val2, qq2, en2);
                        const attn_body::MobaQ qn = attn_body::moba_qload((const attn_body::bf16*)hb, val1 ? qq1 * 256 + (int)(en1 & 255u) : 0);
                        const bool valid = val0; const int qrow = val0 ? qq0 * 256 + (int)(en0 & 255u) : 0; const int rank = (int)(en0 >> 8);
                        attn_body::moba_task<false>(qa, 0, (char*)lds);
                        const bf16* stg = (const bf16*)((char*)lds + attn_body::MB_OST) + wave * 2048; const float* wsf = (const float*)((char*)lds + attn_body::MB_WS) + wave * 64;
                        if (valid && lane < 32) LP[(size_t)rank * (M * 8) + (size_t)bh * SEQ + qrow] = wsf[32 + r32];
#pragma unroll
                        for (int i = 0; i < 4; ++i) { const int row = i * 8 + (lane >> 3), ch = lane & 7; const v4u val = *(const v4u*)(stg + row * 64 + ch * 8);
                            const int pd = __shfl(valid ? ((rank << 20) | qrow) : -1, row);
                            if (pd >= 0) __builtin_nontemporal_store(val, (GAS v4u*)(OP + ((size_t)(pd >> 20) * (M * 8) + (size_t)bh * SEQ + (pd & 0xfffff)) * 64 + ch * 8)); }
                        asm volatile("s_waitcnt lgkmcnt(0)" ::: "memory");
                        qa = qn; val0 = val1; qq0 = qq1; en0 = en1; val1 = val2; qq1 = qq2; en1 = en2;
                    }
#undef MB_RESOLVE
                    __syncthreads();
                    lo = segE; ++L;
                }
            } else for (int rep_ = 0; rep_ < REP_Y; ++rep_) {
#pragma unroll 1
                for (int i = 0; i < 4; ++i) {
                    int lane_ = tid & 63; asm volatile("" : "+v"(lane_)); const int lane = lane_, r32 = lane & 31;
                    const int bh = v >> 3, s = v & 7; const int qb = (i == 0) ? s : (i == 1) ? 15 - s : (i == 2) ? 16 + s : 31 - s;
                    const int grp = wave < 4 ? wave : 11 - wave;
                    const bf16* hb = QKV + (size_t)((bh >> 3) * 48 + (bh & 7)) * SEQ * 64;
                    const int qrow = qb * 256 + grp * 32 + r32;
                    const int nsel = qb < 3 ? qb : 3;
                    const attn_body::MobaQ qa = attn_body::moba_qload((const attn_body::bf16*)hb, qrow);
                    v4u pk[4][3]; float lk[4][3];
#pragma unroll
                    for (int it = 0; it < 4; ++it) { const size_t hr = (size_t)bh * SEQ + qb * 256 + grp * 32 + it * 8 + (lane >> 3);
#pragma unroll
                        for (int k = 0; k < 3; ++k) { pk[it][k] = (v4u){0u, 0u, 0u, 0u}; lk[it][k] = 0.f;
                            if (k < nsel) { lk[it][k] = LP[(size_t)k * (M * 8) + hr]; pk[it][k] = __builtin_nontemporal_load((const GAS v4u*)(OP + ((size_t)k * (M * 8) + hr) * 64 + (lane & 7) * 8)); } } }
                    attn_body::moba_load_block((const attn_body::bf16*)(hb + (size_t)8 * SEQ * 64 + (size_t)qb * 256 * 64), (const attn_body::bf16*)(hb + (size_t)16 * SEQ * 64 + (size_t)qb * 256 * 64), (char*)lds);
                    attn_body::moba_task<true>(qa, grp * 32 + r32, (char*)lds);
                    const bf16* stg = (const bf16*)((char*)lds + attn_body::MB_OST) + wave * 2048; const float* wsf = (const float*)((char*)lds + attn_body::MB_WS) + wave * 64;
#pragma unroll
                    for (int it = 0; it < 4; ++it) { const int row = it * 8 + (lane >> 3), ch = lane & 7; const v4u val = *(const v4u*)(stg + row * 64 + ch * 8);
                        float lt = wsf[32 + row]; float a[8];
                        a[0] = bf_lo(val.x) * lt; a[1] = bf_hi(val.x) * lt; a[2] = bf_lo(val.y) * lt; a[3] = bf_hi(val.y) * lt; a[4] = bf_lo(val.z) * lt; a[5] = bf_hi(val.z) * lt; a[6] = bf_lo(val.w) * lt; a[7] = bf_hi(val.w) * lt;
#pragma unroll
                        for (int k = 0; k < 3; ++k) { const float l2 = lk[it][k]; const v4u p2 = pk[it][k];
                            a[0] += bf_lo(p2.x) * l2; a[1] += bf_hi(p2.x) * l2; a[2] += bf_lo(p2.y) * l2; a[3] += bf_hi(p2.y) * l2; a[4] += bf_lo(p2.z) * l2; a[5] += bf_hi(p2.z) * l2; a[6] += bf_lo(p2.w) * l2; a[7] += bf_hi(p2.w) * l2; lt += l2; }
                        const float rl = 1.0f / lt;
                        v4u o; o.x = pk2(a[0] * rl, a[1] * rl); o.y = pk2(a[2] * rl, a[3] * rl); o.z = pk2(a[4] * rl, a[5] * rl); o.w = pk2(a[6] * rl, a[7] * rl);
                        *(GAS v4u*)(MIX + ((size_t)(bh >> 3) * SEQ + qb * 256 + grp * 32 + row) * DM + (bh & 7) * 64 + ch * 8) = o; }
                    asm volatile("s_waitcnt lgkmcnt(0)" ::: "memory");
                    __syncthreads();
                }
            }
            if (ph == 1) {
                asm volatile("s_waitcnt vmcnt(0)" ::: "memory");
                int lane_ = tid & 63; asm volatile("" : "+v"(lane_)); const int lane = lane_;
                const int bh = v >> 4, b = bh >> 2, dh = bh & 3;
                const int dch = lane & 15;
                const f32x4 sg0 = *(const GAS f32x4*)(args.in[I_SUBLN] + dch * 8), sg1 = *(const GAS f32x4*)(args.in[I_SUBLN] + dch * 8 + 4);
#pragma unroll 1
                for (int w2 = 0; w2 < 2; ++w2) {
                    const int qb = w2 ? 31 - (v & 15) : (v & 15);
#pragma unroll 8
                    for (int it = 0; it < 8; ++it) {
                        const size_t row = (size_t)b * SEQ + qb * 256 + wave * 32 + it * 4 + (lane >> 4);
                        const v4u w0 = __builtin_nontemporal_load((const GAS v4u*)(OST + row * DM + (2 * dh) * 128 + dch * 8));
                        const v4u w1 = __builtin_nontemporal_load((const GAS v4u*)(OST + row * DM + (2 * dh + 1) * 128 + dch * 8));
                        float a[8];
                        a[0] = bf_lo(w0.x) - lam * bf_lo(w1.x); a[1] = bf_hi(w0.x) - lam * bf_hi(w1.x); a[2] = bf_lo(w0.y) - lam * bf_lo(w1.y); a[3] = bf_hi(w0.y) - lam * bf_hi(w1.y);
                        a[4] = bf_lo(w0.z) - lam * bf_lo(w1.z); a[5] = bf_hi(w0.z) - lam * bf_hi(w1.z); a[6] = bf_lo(w0.w) - lam * bf_lo(w1.w); a[7] = bf_hi(w0.w) - lam * bf_hi(w1.w);
                        float ss = 0.f;
#pragma unroll
                        for (int jx = 0; jx < 8; ++jx) ss += a[jx] * a[jx];
                        ss += __shfl_xor(ss, 1); ss += __shfl_xor(ss, 2); ss += __shfl_xor(ss, 4); ss += __shfl_xor(ss, 8);
                        const float rs = __builtin_amdgcn_rsqf(ss * (1.0f / 128.0f) + 1e-6f) * 0.8f;
                        v4u o; o.x = pk2(a[0] * rs * sg0[0], a[1] * rs * sg0[1]); o.y = pk2(a[2] * rs * sg0[2], a[3] * rs * sg0[3]);
                        o.z = pk2(a[4] * rs * sg1[0], a[5] * rs * sg1[1]); o.w = pk2(a[6] * rs * sg1[2], a[7] * rs * sg1[3]);
                        *(GAS v4u*)(MIX + row * DM + 512 + dh * 128 + dch * 8) = o;
                    }
                }
            }
        }
        xcd_barrier(xbar);
    }
    {
        pg8::Gemm g{MIX, Wout_t, M, DM, DM}; pg8::StaticOrder S; S.init(M, DM, G, bx);
        pg8::EpiOut E{x, XN, SS};
        pg8::gemm_phase<pg8::EpiOut, pg8::StaticOrder, PG8_ALIGN, PG8_SP2>(ldsl, g, S, E);
    }
    xcd_barrier(xbar);
    {
        pg8::Gemm g{XN, Wgu_t, M, NGU, DM}; pg8::StaticOrder S; S.init(M, NGU, G, bx);
        pg8::EpiSwiGLU E{SS, HB};
        pg8::gemm_phase<pg8::EpiSwiGLU, pg8::StaticOrder, PG8_ALIGN, PG8_SP2>(ldsl, g, S, E);
    }
    xcd_barrier(xbar);
    {
        pg8::Gemm g{HB, Wdn_t, M, DM, FFN}; pg8::StaticOrder S; S.init(M, DM, G, bx);
        pg8::EpiDown E{XN, out};
        pg8::gemm_phase<pg8::EpiDown, pg8::StaticOrder, PG8_ALIGN, PG8_SP2>(ldsl, g, S, E);
    }
}

extern "C" void kernel_launch(void* const* d_in, const int* in_sizes, int n_in, void* d_out, int out_size, void* d_ws, size_t ws_size, hipStream_t stream) {
    static int grid = 0;
    if (grid == 0) {
        if (n_in != 17 || out_size != M * DM || ws_size < WS_END) { fprintf(stderr, "kernel_launch: unexpected problem (n_in %d out %d ws %zu)\n", n_in, out_size, ws_size); grid = -1; return; }
        int dev = 0, cus = 0, per_cu = 0;
        hipGetDevice(&dev); hipDeviceGetAttribute(&cus, hipDeviceAttributeMultiprocessorCount, dev);
        if (hipFuncSetAttribute((const void*)hymba_fwd, hipFuncAttributeMaxDynamicSharedMemorySize, LDS_BYTES) != hipSuccess) { fprintf(stderr, "kernel_launch: hipFuncSetAttribute failed\n"); grid = -1; return; }
        if (hipOccupancyMaxActiveBlocksPerMultiprocessor(&per_cu, (const void*)hymba_fwd, NWAVES * 64, LDS_BYTES) != hipSuccess || per_cu < 1) { fprintf(stderr, "kernel_launch: occupancy query says %d\n", per_cu); per_cu = 1; }
        (void)hipGetLastError();
        grid = cus;
    }
    if (grid < 0) return;
    Args a{};
    for (int i = 0; i < 17; ++i) a.in[i] = (const float*)d_in[i];
    a.out = (float*)d_out; a.ws = (unsigned char*)d_ws;
    if (hipMemsetAsync((char*)d_ws + WS_BAR, 0, 16384, stream) != hipSuccess) { fprintf(stderr, "kernel_launch: hipMemsetAsync failed\n"); return; }
    void* kargs[] = {&a};
    hipError_t e = hipLaunchCooperativeKernel((const void*)hymba_fwd, dim3(grid), dim3(NWAVES * 64), kargs, LDS_BYTES, stream);
    if (e != hipSuccess) fprintf(stderr, "kernel_launch: cooperative launch failed: %s (grid %d)\n", hipGetErrorString(e), grid);
}
```

```cpp
#include <hip/hip_runtime.h>
#include <cstdio>
#include <cstdint>
namespace pg8 {
#define PG8_LAS __attribute__((address_space(3)))
typedef unsigned short bf16_t;
typedef short bf16x8 __attribute__((ext_vector_type(8)));
typedef float f32x4 __attribute__((ext_vector_type(4)));
typedef unsigned u32x4 __attribute__((ext_vector_type(4)));
constexpr int BM = 256, BK = 64, HALF = 128, HTB = HALF * BK * 2  , STAGE_BYTES = 8 * HTB, NXCD = 8, WGM = 8;

__host__ __device__ __forceinline__ int lds_byte(int r, int c) { const int st = (r >> 4) * 2 + (c >> 5), rr = r & 15, cc = c & 31, ob = rr * 64 + cc * 2; return st * 1024 + (ob ^ (((ob >> 9) & 1) << 5)); }
__host__ __device__ __forceinline__ void stage_rc(int b, int& R, int& C) { const int st = b / 1024, sb = b % 1024, swz = sb ^ (((sb >> 9) & 1) << 5); R = (st >> 1) * 16 + swz / 64; C = (st & 1) * 32 + (swz % 64) / 2; }
__host__ __device__ __forceinline__ int perm32(int rho) { const int n = rho >> 4, i = rho & 15; return 8 * (i >> 2) + 4 * n + (i & 3); }

struct Unit { int pm, pn; };
struct Gemm { const bf16_t* A; const bf16_t* Bt; int M, N, K; };

struct StaticOrder {
    int nM, nN, nwg, G, c;
    __host__ __device__ void init(int M, int N, int G_, int c_) { nM = M / BM; nN = N / BM; nwg = nM * nN; G = G_; c = c_; }
    __host__ __device__ bool next(int i, Unit& u) const {
        const long L = (long)i * G + c; if (L >= nwg) return false;
        int wgid = (int)L; { const int q = nwg / NXCD, r = nwg % NXCD, xcd = wgid % NXCD, off = wgid / NXCD; wgid = (xcd < r ? xcd * (q + 1) : r * (q + 1) + (xcd - r) * q) + off; }
        const int nig = WGM * nN, gid = wgid / nig, fm = gid * WGM, gsz = (nM - fm) < WGM ? (nM - fm) : WGM;
        u.pm = fm + ((wgid % nig) % gsz); u.pn = (wgid % nig) / gsz; return true;
    }
    __device__ __forceinline__ void a_ready(const Unit&) const {}
    __device__ __forceinline__ void done(const Unit&) const {}
};

__device__ __forceinline__ unsigned cvt_pk_bf16(float lo, float hi) { unsigned r; asm volatile("v_cvt_pk_bf16_f32 %0, %1, %2" : "=v"(r) : "v"(lo), "v"(hi)); return r; }
typedef float f32x2 __attribute__((ext_vector_type(2)));
typedef unsigned u32x2 __attribute__((ext_vector_type(2)));
__device__ __forceinline__ float xsum_fq(float s) { s += __shfl_xor(s, 16); s += __shfl_xor(s, 32); return s; }

struct EpiQKV {
    static constexpr bool PERM = true, AFTER_DRAIN = false;
    bf16_t* O; const float* gtab; const float* rcos; const float* rsin; float qscale; float* kpart;
    __device__ __forceinline__ void operator()(const f32x4 (&acc)[2][2][4][2], const Unit& u, int wr, int wc, int fr_, int fq_) const {
        int fr = fr_, fq = fq_; asm volatile("" : "+v"(fr), "+v"(fq));
        const int t = u.pn >> 1;
        const int hh = u.pn * 4 + wc;
        const int row0 = u.pm * BM + wr * 64 + fr;
        if (t == 2 || t == 5) {
#pragma unroll
            for (int ai = 0; ai < 2; ++ai)
#pragma unroll
                for (int m = 0; m < 4; ++m) { const int row = row0 + ai * HALF + m * 16; bf16_t* rowp = O + ((size_t)((row >> 13) * 48 + hh) * 8192 + (row & 8191)) * 64 + 8 * fq;
#pragma unroll
                    for (int bj = 0; bj < 2; ++bj) { const f32x4 v0 = acc[ai][bj][m][0], v1 = acc[ai][bj][m][1]; u32x4 w;
                        w.x = cvt_pk_bf16(v0[0], v0[1]); w.y = cvt_pk_bf16(v0[2], v0[3]); w.z = cvt_pk_bf16(v1[0], v1[1]); w.w = cvt_pk_bf16(v1[2], v1[3]);
                        *(u32x4*)(rowp + bj * 32) = w; } }
        } else {
            const float* g = gtab + t * 64;
            const float sc = (t == 0 || t == 3) ? qscale : 1.0f;
            f32x4 gv[2][2];
#pragma unroll
            for (int bj = 0; bj < 2; ++bj)
#pragma unroll
                for (int n = 0; n < 2; ++n) gv[bj][n] = *(const f32x4*)(g + 32 * bj + 8 * fq + 4 * n) * sc;
#pragma unroll
            for (int ai = 0; ai < 2; ++ai)
#pragma unroll
                for (int m = 0; m < 4; ++m) {
                    const int row = row0 + ai * HALF + m * 16; const int pos = row & 8191;
                    float ss = 0.f;
#pragma unroll
                    for (int bj = 0; bj < 2; ++bj)
#pragma unroll
                        for (int n = 0; n < 2; ++n) { const f32x4 x = acc[ai][bj][m][n]; ss += (x[0] * x[0] + x[1] * x[1]) + (x[2] * x[2] + x[3] * x[3]); }
                    ss = xsum_fq(ss);
                    const float rstd = __builtin_amdgcn_rsqf(ss * (1.0f / 64.0f) + 1e-6f);
                    u32x4 wlo, whi;
#pragma unroll
                    for (int n = 0; n < 2; ++n) {
                        const f32x4 c = *(const f32x4*)(rcos + pos * 32 + 8 * fq + 4 * n), s = *(const f32x4*)(rsin + pos * 32 + 8 * fq + 4 * n);
                        const f32x4 lo = acc[ai][0][m][n] * rstd * gv[0][n], hi = acc[ai][1][m][n] * rstd * gv[1][n];
                        const f32x4 olo = lo * c - hi * s, ohi = hi * c + lo * s;
                        if (n == 0) { wlo.x = cvt_pk_bf16(olo[0], olo[1]); wlo.y = cvt_pk_bf16(olo[2], olo[3]); whi.x = cvt_pk_bf16(ohi[0], ohi[1]); whi.y = cvt_pk_bf16(ohi[2], ohi[3]); }
                        else        { wlo.z = cvt_pk_bf16(olo[0], olo[1]); wlo.w = cvt_pk_bf16(olo[2], olo[3]); whi.z = cvt_pk_bf16(ohi[0], ohi[1]); whi.w = cvt_pk_bf16(ohi[2], ohi[3]); }
                    }
                    bf16_t* rowp = O + ((size_t)((row >> 13) * 48 + hh) * 8192 + pos) * 64 + 8 * fq;
                    *(u32x4*)(rowp) = wlo; *(u32x4*)(rowp + 32) = whi;
                }
            if (t == 1) {
                asm volatile("" ::: "memory");
                f32x4 cs[2][2];
#pragma unroll
                for (int bj = 0; bj < 2; ++bj)
#pragma unroll
                    for (int n = 0; n < 2; ++n) cs[bj][n] = (f32x4){0.f, 0.f, 0.f, 0.f};
#pragma unroll
                for (int ai = 0; ai < 2; ++ai)
#pragma unroll
                    for (int m = 0; m < 4; ++m) {
                        const int row = row0 + ai * HALF + m * 16; const int pos = row & 8191;
                        float ss = 0.f;
#pragma unroll
                        for (int bj = 0; bj < 2; ++bj)
#pragma unroll
                            for (int n = 0; n < 2; ++n) { const f32x4 x = acc[ai][bj][m][n]; ss += (x[0] * x[0] + x[1] * x[1]) + (x[2] * x[2] + x[3] * x[3]); }
                        ss = xsum_fq(ss);
                        const float rstd = __builtin_amdgcn_rsqf(ss * (1.0f / 64.0f) + 1e-6f);
#pragma unroll
                        for (int n = 0; n < 2; ++n) {
                            const f32x4 c = *(const f32x4*)(rcos + pos * 32 + 8 * fq + 4 * n), sn = *(const f32x4*)(rsin + pos * 32 + 8 * fq + 4 * n);
                            const f32x4 lo = acc[ai][0][m][n] * rstd * gv[0][n], hi = acc[ai][1][m][n] * rstd * gv[1][n];
                            cs[0][n] += lo * c - hi * sn; cs[1][n] += hi * c + lo * sn;
                        }
                        asm volatile("" ::: "memory");
                    }
#pragma unroll
                for (int bj = 0; bj < 2; ++bj)
#pragma unroll
                    for (int n = 0; n < 2; ++n)
#pragma unroll
                        for (int j = 0; j < 4; ++j) { float v = cs[bj][n][j]; v += __shfl_xor(v, 1); v += __shfl_xor(v, 2); v += __shfl_xor(v, 4); v += __shfl_xor(v, 8); cs[bj][n][j] = v; }
                if (fr == 0) { float* kp = kpart + ((size_t)(((u.pm >> 5) * 8 + (hh - 8)) * 32 + (u.pm & 31)) * 2 + wr) * 64 + 8 * fq;
                    *(f32x4*)(kp) = cs[0][0]; *(f32x4*)(kp + 4) = cs[0][1]; *(f32x4*)(kp + 32) = cs[1][0]; *(f32x4*)(kp + 36) = cs[1][1]; }
            }
        }
    }
};
struct EpiOut {
    static constexpr bool PERM = true, AFTER_DRAIN = false;
    const float* X; bf16_t* XB; float* SS;
    __device__ __forceinline__ void operator()(const f32x4 (&acc)[2][2][4][2], const Unit& u, int wr, int wc, int fr, int fq) const {
        const int col0 = u.pn * 256 + wc * 32 + 8 * fq;
        const int row0 = u.pm * BM + wr * 64 + fr;
#pragma unroll
        for (int ai = 0; ai < 2; ++ai)
#pragma unroll
            for (int m = 0; m < 4; ++m) { const int row = row0 + ai * HALF + m * 16; const size_t off = (size_t)row * 1024 + col0; float ss = 0.f;
#pragma unroll
                for (int bj = 0; bj < 2; ++bj) {
                    const f32x4 v0 = __builtin_nontemporal_load((const f32x4*)(X + off + bj * HALF)) + acc[ai][bj][m][0], v1 = __builtin_nontemporal_load((const f32x4*)(X + off + bj * HALF + 4)) + acc[ai][bj][m][1];
                    ss += (v0[0] * v0[0] + v0[1] * v0[1]) + (v0[2] * v0[2] + v0[3] * v0[3]) + (v1[0] * v1[0] + v1[1] * v1[1]) + (v1[2] * v1[2] + v1[3] * v1[3]);
                    u32x4 w; w.x = cvt_pk_bf16(v0[0], v0[1]); w.y = cvt_pk_bf16(v0[2], v0[3]); w.z = cvt_pk_bf16(v1[0], v1[1]); w.w = cvt_pk_bf16(v1[2], v1[3]);
                    *(u32x4*)(XB + off + bj * HALF) = w; }
                ss = xsum_fq(ss);
                if (fq == 0) SS[(size_t)row * 16 + u.pn * 4 + wc] = ss; }
    }
};
struct EpiSwiGLU {
    static constexpr bool PERM = true, AFTER_DRAIN = false;
    const float* SS; bf16_t* H;
    __device__ __forceinline__ void operator()(const f32x4 (&acc)[2][2][4][2], const Unit& u, int wr, int wc, int fr, int fq) const {
        const int col0 = u.pn * 128 + wc * 32 + 8 * fq;
        const int row0 = u.pm * BM + wr * 64 + fr;
#pragma unroll
        for (int ai = 0; ai < 2; ++ai)
#pragma unroll
            for (int m = 0; m < 4; ++m) { const int row = row0 + ai * HALF + m * 16;
                const f32x4* sp = (const f32x4*)(SS + (size_t)row * 16); const f32x4 a = sp[0], b = sp[1], c = sp[2], d = sp[3];
                const float tot = ((a[0] + a[1]) + (a[2] + a[3])) + ((b[0] + b[1]) + (b[2] + b[3])) + ((c[0] + c[1]) + (c[2] + c[3])) + ((d[0] + d[1]) + (d[2] + d[3]));
                const float rstd = __builtin_amdgcn_rsqf(tot * (1.0f / 1024.0f) + 1e-6f);
                unsigned w[4];
                const float rneg = -1.4426950408889634f * rstd, r2 = rstd * rstd;
#pragma unroll
                for (int n = 0; n < 2; ++n) { const f32x4 ga = acc[ai][0][m][n], gu = ga * acc[ai][1][m][n] * r2, ea = ga * rneg; float h[4];
#pragma unroll
                    for (int j = 0; j < 4; ++j) h[j] = gu[j] * __builtin_amdgcn_rcpf(1.0f + __builtin_amdgcn_exp2f(ea[j]));
                    w[2 * n] = cvt_pk_bf16(h[0], h[1]); w[2 * n + 1] = cvt_pk_bf16(h[2], h[3]); }
                *(u32x4*)(H + (size_t)row * 2816 + col0) = (u32x4){w[0], w[1], w[2], w[3]}; }
    }
};
struct EpiDown {
    static constexpr bool PERM = true, AFTER_DRAIN = false;
    const bf16_t* XB; float* Y;
    __device__ __forceinline__ void operator()(const f32x4 (&acc)[2][2][4][2], const Unit& u, int wr, int wc, int fr, int fq) const {
        const int col0 = u.pn * 256 + wc * 32 + 8 * fq;
        const int row0 = u.pm * BM + wr * 64 + fr;
#pragma unroll
        for (int ai = 0; ai < 2; ++ai)
#pragma unroll
            for (int m = 0; m < 4; ++m) { const size_t off = (size_t)(row0 + ai * HALF + m * 16) * 1024 + col0;
#pragma unroll
                for (int bj = 0; bj < 2; ++bj) {
                    const u32x4 xb = __builtin_nontemporal_load((const u32x4*)(XB + off + bj * HALF));
                    const f32x4 x0 = {__builtin_bit_cast(float, xb.x << 16), __builtin_bit_cast(float, xb.x & 0xffff0000u), __builtin_bit_cast(float, xb.y << 16), __builtin_bit_cast(float, xb.y & 0xffff0000u)};
                    const f32x4 x1 = {__builtin_bit_cast(float, xb.z << 16), __builtin_bit_cast(float, xb.z & 0xffff0000u), __builtin_bit_cast(float, xb.w << 16), __builtin_bit_cast(float, xb.w & 0xffff0000u)};
                    const f32x4 v0 = x0 + acc[ai][bj][m][0], v1 = x1 + acc[ai][bj][m][1];
                    __builtin_nontemporal_store(v0, (f32x4*)(Y + off + bj * HALF)); __builtin_nontemporal_store(v1, (f32x4*)(Y + off + bj * HALF + 4)); } }
    }
};

template <class Epi, class Sched, bool ALIGN_EPI = false, bool SP2 = false>
__device__ __forceinline__ void gemm_phase(PG8_LAS unsigned char* lds, const Gemm g, const Sched& S, const Epi& E) {
    int tid_ = threadIdx.x; asm volatile("" : "+v"(tid_));
    const int tid = tid_, wid = __builtin_amdgcn_readfirstlane(tid >> 6), lane = tid & 63, wr = wid >> 2, wc = wid & 3, fr = lane & 15, fq = lane >> 4;
    const int K = g.K, nt = K / BK;
    unsigned voffA[2], voffB[2];
#pragma unroll
    for (int i = 0; i < 2; ++i) { int R, C; stage_rc(tid * 16 + i * 8192, R, C); const int Rb = Epi::PERM ? ((R & ~31) + perm32(R & 31)) : R;
        voffA[i] = (unsigned)(R * K + C) * 2u; voffB[i] = (unsigned)(Rb * K + C) * 2u; }
    const size_t kstep = (size_t)(BK * 2);
    const size_t hstep = (size_t)HALF * K * 2;
    const size_t tstep = 2 * hstep;
    const unsigned ldsw = (unsigned)wid * 1024u;
    const int aoff = lds_byte(wr * 64 + fr, fq * 8), boff = lds_byte(wc * 32 + fr, fq * 8);
#define PG8_SA(b, h) (((b) * 2 + (h)) * HTB)
#define PG8_SB(b, h) ((4 + (b) * 2 + (h)) * HTB)
#define PG8_STAGE(bufoff, gbase, voff) do { _Pragma("unroll") for (int _i = 0; _i < 2; ++_i) \
        __builtin_amdgcn_global_load_lds((const unsigned*)((const char*)(gbase) + (voff)[_i]), (PG8_LAS unsigned*)(lds + (bufoff) + ldsw + _i * 8192), 16, 0, 0); } while (0)
#define PG8_LDA(dst, b, h) do { _Pragma("unroll") for (int m = 0; m < 4; ++m) _Pragma("unroll") for (int k = 0; k < 2; ++k) dst[m][k] = *(const PG8_LAS bf16x8*)(lds + PG8_SA(b, h) + aoff + m * 2048 + k * 1024); } while (0)
#define PG8_LDB(dst, b, h) do { _Pragma("unroll") for (int n = 0; n < 2; ++n) _Pragma("unroll") for (int k = 0; k < 2; ++k) dst[n][k] = *(const PG8_LAS bf16x8*)(lds + PG8_SB(b, h) + boff + n * 2048 + k * 1024); } while (0)
#define PG8_MMA(ai, bj, At, Bt) do { __builtin_amdgcn_s_setprio(1); _Pragma("unroll") for (int m = 0; m < 4; ++m) _Pragma("unroll") for (int n = 0; n < 2; ++n) _Pragma("unroll") for (int k = 0; k < 2; ++k) \
        acc[ai][bj][m][n] = __builtin_amdgcn_mfma_f32_16x16x32_bf16(Bt[n][k], At[m][k], acc[ai][bj][m][n], 0, 0, 0); __builtin_amdgcn_s_setprio(0); } while (0)
#define PG8_WAIT_V(n) asm volatile("s_waitcnt vmcnt(" #n ")" ::: "memory")
#define PG8_WAIT_L(n) asm volatile("s_waitcnt lgkmcnt(" #n ")" ::: "memory")
#define PG8_BAR __builtin_amdgcn_s_barrier()
#define PG8_SCHED __builtin_amdgcn_sched_barrier(0)
    Unit cur, nxt; int ui = 0;
    if (!S.next(0, cur)) return;
    f32x4 acc[2][2][4][2];
#pragma unroll
    for (int a = 0; a < 2; ++a)
#pragma unroll
        for (int b = 0; b < 2; ++b)
#pragma unroll
            for (int m = 0; m < 4; ++m)
#pragma unroll
                for (int n = 0; n < 2; ++n) acc[a][b][m][n] = (f32x4){0.f, 0.f, 0.f, 0.f};
    bf16x8 At[4][2], B0[2][2], B1[2][2];
    const char* cA = (const char*)g.A + (size_t)cur.pm * tstep; const char* cB = (const char*)g.Bt + (size_t)cur.pn * tstep;
    S.a_ready(cur);
    if constexpr (SP2) {
        PG8_STAGE(PG8_SB(0, 0), cB, voffB); PG8_STAGE(PG8_SB(0, 1), cB + hstep, voffB); PG8_STAGE(PG8_SA(0, 0), cA, voffA); PG8_STAGE(PG8_SA(0, 1), cA + hstep, voffA);
        if (wr == 1) PG8_BAR;
        PG8_WAIT_V(2); PG8_BAR;
        PG8_STAGE(PG8_SB(1, 0), cB + kstep, voffB); PG8_STAGE(PG8_SA(1, 0), cA + kstep, voffA); PG8_STAGE(PG8_SB(1, 1), cB + hstep + kstep, voffB);
        PG8_WAIT_V(6); PG8_BAR;
    } else {
        PG8_STAGE(PG8_SB(0, 0), cB, voffB); PG8_STAGE(PG8_SA(0, 0), cA, voffA); PG8_STAGE(PG8_SB(0, 1), cB + hstep, voffB); PG8_STAGE(PG8_SA(0, 1), cA + hstep, voffA);
        if (wr == 1) PG8_BAR;
        PG8_WAIT_V(4); PG8_BAR;
        PG8_STAGE(PG8_SB(1, 0), cB + kstep, voffB); PG8_STAGE(PG8_SA(1, 0), cA + kstep, voffA); PG8_STAGE(PG8_SB(1, 1), cB + hstep + kstep, voffB);
        PG8_WAIT_V(6); PG8_BAR;
    }
    for (;;) {
        const bool has_next = S.next(ui + 1, nxt);
        const char* nA = has_next ? (const char*)g.A + (size_t)nxt.pm * tstep : cA; const char* nB = has_next ? (const char*)g.Bt + (size_t)nxt.pn * tstep : cB;
        for (int t = 0; t < nt; t += 2) {
            const bool last = (t == nt - 2);
            const char* a1 = cA + (size_t)(t + 1) * kstep;
            const char* a2 = last ? nA : cA + (size_t)(t + 2) * kstep; const char* b2 = last ? nB : cB + (size_t)(t + 2) * kstep;
            const char* a3 = a2 + kstep; const char* b3 = b2 + kstep;
            if (last && has_next) S.a_ready(nxt);
            if constexpr (SP2) {
            PG8_LDB(B0, 0, 0); PG8_LDB(B1, 0, 1); PG8_SCHED; PG8_LDA(At, 0, 0); PG8_STAGE(PG8_SA(1, 1), a1 + hstep, voffA);
            PG8_WAIT_V(8); PG8_WAIT_L(0); PG8_BAR; PG8_MMA(0, 0, At, B0); PG8_MMA(0, 1, At, B1); PG8_BAR; PG8_SCHED;
            PG8_LDA(At, 0, 1); PG8_STAGE(PG8_SB(0, 0), b2, voffB); PG8_STAGE(PG8_SB(0, 1), b2 + hstep, voffB); PG8_STAGE(PG8_SA(0, 0), a2, voffA);
            PG8_WAIT_V(8); PG8_WAIT_L(0); PG8_BAR; PG8_MMA(1, 0, At, B0); PG8_MMA(1, 1, At, B1); PG8_BAR; PG8_SCHED;
            PG8_LDB(B0, 1, 0); PG8_LDB(B1, 1, 1); PG8_SCHED; PG8_LDA(At, 1, 0); PG8_STAGE(PG8_SA(0, 1), a2 + hstep, voffA);
            PG8_WAIT_V(8); PG8_WAIT_L(0); PG8_BAR; PG8_MMA(0, 0, At, B0); PG8_MMA(0, 1, At, B1); PG8_BAR; PG8_SCHED;
            PG8_LDA(At, 1, 1); PG8_STAGE(PG8_SB(1, 0), b3, voffB); PG8_STAGE(PG8_SB(1, 1), b3 + hstep, voffB); PG8_STAGE(PG8_SA(1, 0), a3, voffA);
            PG8_WAIT_V(8); PG8_WAIT_L(0); PG8_BAR; PG8_MMA(1, 0, At, B0); PG8_MMA(1, 1, At, B1); PG8_BAR; PG8_SCHED;
            } else {
            PG8_LDB(B0, 0, 0); PG8_SCHED; PG8_LDA(At, 0, 0); PG8_STAGE(PG8_SA(1, 1), a1 + hstep, voffA);
            PG8_WAIT_L(8); PG8_BAR; PG8_WAIT_L(0); PG8_MMA(0, 0, At, B0); PG8_BAR; PG8_SCHED;
            PG8_LDB(B1, 0, 1); PG8_STAGE(PG8_SB(0, 0), b2, voffB);
            PG8_BAR; PG8_WAIT_L(0); PG8_MMA(0, 1, At, B1); PG8_BAR;
            PG8_LDA(At, 0, 1); PG8_STAGE(PG8_SA(0, 0), a2, voffA);
            PG8_BAR; PG8_WAIT_L(0); PG8_MMA(1, 0, At, B0); PG8_BAR; PG8_SCHED;
            PG8_STAGE(PG8_SB(0, 1), b2 + hstep, voffB);
            PG8_WAIT_V(6); PG8_BAR; PG8_MMA(1, 1, At, B1); PG8_BAR;
            PG8_LDB(B0, 1, 0); PG8_SCHED; PG8_LDA(At, 1, 0); PG8_STAGE(PG8_SA(0, 1), a2 + hstep, voffA);
            PG8_WAIT_L(8); PG8_BAR; PG8_WAIT_L(0); PG8_MMA(0, 0, At, B0); PG8_BAR; PG8_SCHED;
            PG8_LDB(B1, 1, 1); PG8_STAGE(PG8_SB(1, 0), b3, voffB);
            PG8_BAR; PG8_WAIT_L(0); PG8_MMA(0, 1, At, B1); PG8_BAR;
            PG8_LDA(At, 1, 1); PG8_STAGE(PG8_SA(1, 0), a3, voffA);
            PG8_BAR; PG8_WAIT_L(0); PG8_MMA(1, 0, At, B0); PG8_BAR; PG8_SCHED;
            PG8_STAGE(PG8_SB(1, 1), b3 + hstep, voffB);
            PG8_WAIT_V(6); PG8_BAR; PG8_MMA(1, 1, At, B1); PG8_BAR;
            }
        }
        if constexpr (ALIGN_EPI) { if (wr == 0) PG8_BAR; }
        if constexpr (!Epi::AFTER_DRAIN) { E(acc, cur, wr, wc, fr, fq); S.done(cur); }
        if (!has_next) break;
#pragma unroll
        for (int a = 0; a < 2; ++a)
#pragma unroll
            for (int b = 0; b < 2; ++b)
#pragma unroll
                for (int m = 0; m < 4; ++m)
#pragma unroll
                    for (int n = 0; n < 2; ++n) acc[a][b][m][n] = (f32x4){0.f, 0.f, 0.f, 0.f};
        cur = nxt; cA = nA; cB = nB; ++ui;
        if constexpr (ALIGN_EPI) { if (wr == 1) PG8_BAR; }
    }
    PG8_WAIT_V(0);
    if constexpr (!ALIGN_EPI) { if (wr == 0) PG8_BAR; }
    PG8_BAR;
    if constexpr (Epi::AFTER_DRAIN) { E.fused(acc, cur, wr, wc, fr, fq, lds, wid, lane); S.done(cur); }
#undef PG8_SA
#undef PG8_SB
#undef PG8_STAGE
#undef PG8_LDA
#undef PG8_LDB
#undef PG8_MMA
#undef PG8_WAIT_V
#undef PG8_WAIT_L
#undef PG8_BAR
#undef PG8_SCHED
}
}

#ifndef PG8_SP2
#define PG8_SP2 true
#endif
#ifndef PG8_ALIGN
#define PG8_ALIGN true
#endif
#include <hip/hip_bf16.h>
#include <cmath>
namespace attn_body {
using bf16=__hip_bfloat16;
using bf16x8=__attribute__((ext_vector_type(8)))short;
using s16x4=__attribute__((ext_vector_type(4)))short;
using f32x16=__attribute__((ext_vector_type(16)))float;
using u32x4=__attribute__((ext_vector_type(4)))unsigned;
constexpr int SEQ=8192,D=64,PQ=64,PO=1024;
constexpr int NW=8,QBLK=32,QB=QBLK*NW,KVBLK=64,NQB=SEQ/QB;
constexpr int ATTN_UNIT_ROWS=QB;
__device__ __forceinline__ int crow(int r,int hi){return (r&3)+8*(r>>2)+4*hi;}
#define SBAR() __builtin_amdgcn_sched_barrier(0)
__device__ __forceinline__ void cmask(f32x16&p0,f32x16&p1,int jb,int qrel,int hi){
  const float NEG=-INFINITY; int kb=64*jb+4*hi;
  #pragma unroll
  for(int r=0;r<16;++r){int kv=kb+(r&3)+8*(r>>2); if(kv>qrel)p0[r]=NEG; if(kv+32>qrel)p1[r]=NEG;}
}

constexpr int NSLOT=3, SLOTB=8192;
constexpr int LDS_K=0, LDS_V=NSLOT*SLOTB, LDS_WS=2*NSLOT*SLOTB, LDS_OST=LDS_WS+NW*64*4, LDS_BYTES=LDS_OST+NW*4096;
constexpr float C2=0.125f*1.4426950408889634f;
__device__ __forceinline__ void glds16(const void*gsrc,unsigned lds_dst){unsigned keep;
  asm volatile("s_mov_b32 %0, m0\n\ts_mov_b32 m0, %2\n\ts_nop 0\n\tglobal_load_lds_dwordx4 %1, off\n\ts_mov_b32 m0, %0":"=&s"(keep):"v"(gsrc),"s"(lds_dst):"memory");}
__device__ __forceinline__ float max3f(float a,float b,float c){float r;asm("v_max3_f32 %0, %1, %2, %3":"=v"(r):"v"(a),"v"(b),"v"(c));return r;}
__device__ __forceinline__ float max2f(float a,float b){float r;asm("v_max_f32_e32 %0, %1, %2":"=v"(r):"v"(a),"v"(b));return r;}
__device__ __forceinline__ float fadd_s(float a,float b){float r;asm("v_add_f32_e32 %0, %1, %2":"=v"(r):"v"(a),"v"(b));return r;}
__device__ __forceinline__ float fsub_s(float a,float b){float r;asm("v_sub_f32_e32 %0, %1, %2":"=v"(r):"v"(a),"v"(b));return r;}
typedef float f32x2_t __attribute__((ext_vector_type(2))); typedef __bf16 bf16x2_t __attribute__((ext_vector_type(2)));
__device__ __forceinline__ unsigned cvtpk_s(float lo,float hi){f32x2_t v={lo,hi};bf16x2_t b=__builtin_convertvector(v,bf16x2_t);return __builtin_bit_cast(unsigned,b);}
#define WAIT_BAR(N) asm volatile("s_waitcnt vmcnt(" #N ") lgkmcnt(0)\n\ts_barrier":::"memory")

__device__ __forceinline__ void qkt(f32x16&p0,f32x16&p1,const char*Kslot,const bf16x8*qr,const f32x16&negm,int r32,int hi){
  const char*kb=Kslot+hi*1024+r32*16;
  #pragma unroll
  for(int d0=0;d0<4;++d0){
    const bf16x8 b0=*reinterpret_cast<const bf16x8*>(kb+d0*2048);
    const bf16x8 b1=*reinterpret_cast<const bf16x8*>(kb+d0*2048+512);
    if(d0==0){p0=__builtin_amdgcn_mfma_f32_32x32x16_bf16(b0,qr[0],negm,0,0,0);p1=__builtin_amdgcn_mfma_f32_32x32x16_bf16(b1,qr[0],negm,0,0,0);}
    else{p0=__builtin_amdgcn_mfma_f32_32x32x16_bf16(b0,qr[d0],p0,0,0,0);p1=__builtin_amdgcn_mfma_f32_32x32x16_bf16(b1,qr[d0],p1,0,0,0);}}
}
typedef __attribute__((address_space(3))) const char* lds_cptr;
typedef short v4i16_t __attribute__((ext_vector_type(4)));
__device__ __forceinline__ void kload8(bf16x8*kf,lds_cptr kp){
  kf[0]=*(const __attribute__((address_space(3))) bf16x8*)(kp);      kf[1]=*(const __attribute__((address_space(3))) bf16x8*)(kp+512);
  kf[2]=*(const __attribute__((address_space(3))) bf16x8*)(kp+2048); kf[3]=*(const __attribute__((address_space(3))) bf16x8*)(kp+2560);
  kf[4]=*(const __attribute__((address_space(3))) bf16x8*)(kp+4096); kf[5]=*(const __attribute__((address_space(3))) bf16x8*)(kp+4608);
  kf[6]=*(const __attribute__((address_space(3))) bf16x8*)(kp+6144); kf[7]=*(const __attribute__((address_space(3))) bf16x8*)(kp+6656);
}
__device__ __forceinline__ void kload2(bf16x8*kf,lds_cptr kp,int j){ kf[2*j]=*(const __attribute__((address_space(3))) bf16x8*)(kp+j*2048); kf[2*j+1]=*(const __attribute__((address_space(3))) bf16x8*)(kp+j*2048+512); }
__device__ __forceinline__ s16x4 vtr(lds_cptr p){ return __builtin_bit_cast(s16x4,__builtin_amdgcn_ds_read_tr16_b64_v4i16((__attribute__((address_space(3))) v4i16_t*)p)); }
__device__ __forceinline__ float rowmax(const f32x16&p0,const f32x16&p1){
  float a=max3f(p0[0],p0[1],p1[0]),b=max3f(p0[2],p0[3],p1[1]);a=max3f(a,p1[2],p1[3]);
  #pragma unroll
  for(int r=4;r<16;r+=4){a=max3f(a,p0[r],p0[r+1]);b=max3f(b,p0[r+2],p0[r+3]);a=max3f(a,p1[r],p1[r+1]);b=max3f(b,p1[r+2],p1[r+3]);}
  const float m=max2f(a,b);
  auto rr=__builtin_amdgcn_permlane32_swap(__float_as_uint(m),__float_as_uint(m),false,false);
  return max2f(__uint_as_float(rr[0]),__uint_as_float(rr[1]));
}
__device__ __forceinline__ void pv(f32x16*o,int vb,bf16x8 pa0,bf16x8 pa1,bf16x8 pa2,bf16x8 pa3){
  #pragma unroll
  for(int d0=0;d0<2;++d0){s16x4 lo[4],hi[4];
    #pragma unroll
    for(int ks=0;ks<4;++ks){
      asm volatile("ds_read_b64_tr_b16 %0,%1 offset:%c2":"=&v"(lo[ks]):"v"(vb),"i"(d0*4096+ks*1024):"memory");
      asm volatile("ds_read_b64_tr_b16 %0,%1 offset:%c2":"=&v"(hi[ks]):"v"(vb),"i"(d0*4096+ks*1024+512):"memory");}
    asm volatile("s_waitcnt lgkmcnt(0)":::"memory");SBAR();
    #define PK(k) (bf16x8){lo[k][0],lo[k][1],lo[k][2],lo[k][3],hi[k][0],hi[k][1],hi[k][2],hi[k][3]}
    o[d0]=__builtin_amdgcn_mfma_f32_32x32x16_bf16(pa0,PK(0),o[d0],0,0,0);
    o[d0]=__builtin_amdgcn_mfma_f32_32x32x16_bf16(pa1,PK(1),o[d0],0,0,0);
    o[d0]=__builtin_amdgcn_mfma_f32_32x32x16_bf16(pa2,PK(2),o[d0],0,0,0);
    o[d0]=__builtin_amdgcn_mfma_f32_32x32x16_bf16(pa3,PK(3),o[d0],0,0,0);
    #undef PK
  }
}

__device__ __forceinline__ void pv2(f32x16&oa,f32x16&ob,int vb,bf16x8 pa0,bf16x8 pa1,bf16x8 pa2,bf16x8 pa3){
  #pragma unroll
  for(int d0=0;d0<2;++d0){s16x4 lo[4],hi[4];
    #pragma unroll
    for(int ks=0;ks<4;++ks){
      asm volatile("ds_read_b64_tr_b16 %0,%1 offset:%c2":"=&v"(lo[ks]):"v"(vb),"i"(d0*4096+ks*1024):"memory");
      asm volatile("ds_read_b64_tr_b16 %0,%1 offset:%c2":"=&v"(hi[ks]):"v"(vb),"i"(d0*4096+ks*1024+512):"memory");}
    asm volatile("s_waitcnt lgkmcnt(0)":::"memory");SBAR();
    #define PK(k) (bf16x8){lo[k][0],lo[k][1],lo[k][2],lo[k][3],hi[k][0],hi[k][1],hi[k][2],hi[k][3]}
    f32x16 acc=d0?ob:oa;
    acc=__builtin_amdgcn_mfma_f32_32x32x16_bf16(pa0,PK(0),acc,0,0,0);
    acc=__builtin_amdgcn_mfma_f32_32x32x16_bf16(pa1,PK(1),acc,0,0,0);
    acc=__builtin_amdgcn_mfma_f32_32x32x16_bf16(pa2,PK(2),acc,0,0,0);
    acc=__builtin_amdgcn_mfma_f32_32x32x16_bf16(pa3,PK(3),acc,0,0,0);
    if(d0)ob=acc;else oa=acc;
    #undef PK
  }
}
#ifndef ATTN_STORE16
#define ATTN_STORE16(p,v) (*(u32x4*)(p)=(v))
#endif
template<int THRL> __device__ __forceinline__ void attn_unit(int qb,const bf16*Qh,const bf16*__restrict__ Kh,const bf16*__restrict__ Vh,bf16*Oh,char*shm,unsigned selmask){
  int tid_=threadIdx.x; asm volatile("":"+v"(tid_)); const int tid=tid_,lane=tid&63,r32=lane&31,hi=lane>>5; const int wid=__builtin_amdgcn_readfirstlane(tid>>6);
  const int q0=qb*QB;
  const bf16*Qw=Qh+(long)(q0+wid*QBLK)*PQ;
  const unsigned lds0=(unsigned)(uintptr_t)shm;
  float*wsf=(float*)(shm+LDS_WS)+wid*64;
  const bf16*ksrc=Kh+(long)lane*PQ+wid*8;
  const bf16*vsrc=Vh+(long)(16*(wid&3)+(lane>>2))*PQ+(wid>>2)*32+(lane&3)*8;
  const unsigned kdst=lds0+LDS_K+wid*1024, vdst=lds0+LDS_V+wid*1024;
  #define DMA_K(t,slot) glds16(ksrc+(long)(t)*KVBLK*PQ,(unsigned)__builtin_amdgcn_readfirstlane(kdst+(slot)))
  #define DMA_V(t,slot) glds16(vsrc+(long)(t)*KVBLK*PQ,(unsigned)__builtin_amdgcn_readfirstlane(vdst+(slot)))
  const int vb0=(int)(lds0+LDS_V)+((lane>>4)&1)*32+(lane&3)*8+(4*hi+((lane&15)>>2))*64;
  const char*Kbase=shm+LDS_K; bf16x8 kf[8];
  const lds_cptr shm3=(lds_cptr)shm; const lds_cptr kp0=shm3+LDS_K+hi*1024+r32*16; const lds_cptr vp0=shm3+LDS_V+((lane>>4)&1)*32+(lane&3)*8+(4*hi+((lane&15)>>2))*64;
  const int NT=(q0+QB)/KVBLK;
  DMA_K(0,0);DMA_V(0,0);DMA_K(1,SLOTB);
  bf16x8 qr[4];
  #pragma unroll
  for(int d0=0;d0<4;++d0)qr[d0]=*reinterpret_cast<const bf16x8*>(&Qw[(long)r32*PQ+d0*16+hi*8]);
  float l_reg=0.f;f32x16 o[2];o[0]=f32x16{};o[1]=f32x16{};f32x16 negm;
  #define SETBIAS(t) do{ const float bv_=((selmask>>((t)>>2))&1u)?0.f:-INFINITY; _Pragma("unroll") for(int r_=0;r_<16;++r_)negm[r_]=bv_; asm volatile("":"+v"(negm)); }while(0)
  SETBIAS(0);
  const int qrel=wid*QBLK+r32;
  #define CMASK(P0,P1,t) do{int jb_=(t)-(NT-4); if(jb_>=0)cmask(P0,P1,jb_,qrel,hi);}while(0)
  #define START(P0,P1) do{ _Pragma("unroll") for(int r=0;r<16;++r)P0[r]=__builtin_amdgcn_exp2f(P0[r]); }while(0)
  #define RESC() do{}while(0)
  f32x16 pA0,pA1,pB0,pB1;
  int sl_prev=0,sl_cur=0,sl_next=SLOTB;
  #define ROT() do{sl_prev=sl_cur;sl_cur=sl_next;sl_next=(sl_next==(NSLOT-1)*SLOTB)?0:sl_next+SLOTB;}while(0)
  DMA_K(2,2*SLOTB);
  WAIT_BAR(3);
  qkt(pA0,pA1,Kbase,qr,negm,r32,hi);asm volatile("s_nop 15\n\ts_nop 7":"+v"(pA0),"+v"(pA1));CMASK(pA0,pA1,0);
  START(pA0,pA1);
  _Pragma("unroll") for(int r=0;r<16;++r)pA1[r]=__builtin_amdgcn_exp2f(pA1[r]);
  WAIT_BAR(0);
  DMA_K(3,0);DMA_V(1,SLOTB);
  ROT();
  kload8(kf,kp0+sl_cur);
  WAIT_BAR(2);
  s16x4 vlo[8],vhi[8]; u32x4 pw0,pw1,pw2,pw3;
  #define PKW(P,B) cvtpk_s(P[B],P[B+1])
  #define PAF(k) __builtin_bit_cast(bf16x8,pw##k)
  #define VFR(i) (bf16x8){vlo[i][0],vlo[i][1],vlo[i][2],vlo[i][3],vhi[i][0],vhi[i][1],vhi[i][2],vhi[i][3]}
  #define PIN(x) asm volatile("":"+v"(x))
  #define MX3(a,b,c) __builtin_fmaxf(__builtin_fmaxf((a),(b)),(c))
  #define GAPA(MF,A0,A1,A2,A3,W0,W1,PW) do{ MF; sacc+=A0; sacc+=A1; sacc+=A2; sacc+=A3; PIN(sacc); W0; W1; PIN(PW); SBAR(); }while(0)
  #define EX(v) __builtin_amdgcn_exp2f(v)
  #define GAPB(MF,X,B) do{ MF; X[B]=EX(X[B]); X[B+1]=EX(X[B+1]); X[B+2]=EX(X[B+2]); X[B+3]=EX(X[B+3]); PIN(X); SBAR(); }while(0)
  #define VRD(i) do{ vlo[i]=vtr(vp_+(((i)>>2)*4096+((i)&3)*1024)); vhi[i]=vtr(vp_+(((i)>>2)*4096+((i)&3)*1024+512)); }while(0)
  #define KRD(G,j) do{ if(G){ kload2(kf,kp0+sl_next,j); SBAR(); } }while(0)
  #define STEP(C0,C1,P0,P1,t,GK,GV,GL) do{ SBAR(); if((((t))&3)==0){ SETBIAS(t); } SBAR(); \
    const lds_cptr vp_=vp0+sl_prev; \
    VRD(0); SBAR(); float sacc=(P0[0]+P0[1]); \
    GAPA(C0=__builtin_amdgcn_mfma_f32_32x32x16_bf16(kf[0],qr[0],negm,0,0,0), P0[2],P0[3],P0[4],P0[5],     pw0[0]=PKW(P0,0), pw0[1]=PKW(P0,2), pw0); \
    VRD(4); SBAR(); GAPA(C1=__builtin_amdgcn_mfma_f32_32x32x16_bf16(kf[1],qr[0],negm,0,0,0), P0[6],P0[7],P0[8],P0[9],     pw0[2]=PKW(P0,4), pw0[3]=PKW(P0,6), pw0); \
    VRD(1); SBAR(); GAPA(C0=__builtin_amdgcn_mfma_f32_32x32x16_bf16(kf[2],qr[1],C0,0,0,0),   P0[10],P0[11],P0[12],P0[13], pw1[0]=PKW(P0,8), pw1[1]=PKW(P0,10), pw1); \
    VRD(5); SBAR(); GAPA(C1=__builtin_amdgcn_mfma_f32_32x32x16_bf16(kf[3],qr[1],C1,0,0,0),   P0[14],P0[15],P1[0],P1[1],   pw1[2]=PKW(P0,12),pw1[3]=PKW(P0,14), pw1); \
    VRD(2); SBAR(); GAPA(C0=__builtin_amdgcn_mfma_f32_32x32x16_bf16(kf[4],qr[2],C0,0,0,0),   P1[2],P1[3],P1[4],P1[5],     pw2[0]=PKW(P1,0), pw2[1]=PKW(P1,2), pw2); \
    VRD(6); SBAR(); GAPA(C1=__builtin_amdgcn_mfma_f32_32x32x16_bf16(kf[5],qr[2],C1,0,0,0),   P1[6],P1[7],P1[8],P1[9],     pw2[2]=PKW(P1,4), pw2[3]=PKW(P1,6), pw2); \
    VRD(3); SBAR(); GAPA(C0=__builtin_amdgcn_mfma_f32_32x32x16_bf16(kf[6],qr[3],C0,0,0,0),   P1[10],P1[11],P1[12],P1[13], pw3[0]=PKW(P1,8), pw3[1]=PKW(P1,10), pw3); \
    VRD(7); SBAR(); GAPA(C1=__builtin_amdgcn_mfma_f32_32x32x16_bf16(kf[7],qr[3],C1,0,0,0),   P1[14],P1[15],0.f,0.f,       pw3[2]=PKW(P1,12),pw3[3]=PKW(P1,14), pw3); \
    l_reg+=sacc; \
    if(GK){DMA_K((t)+3,sl_cur);} if(GV){DMA_V((t)+1,sl_next);} \
    CMASK(C0,C1,t); \
    SBAR(); \
    GAPB(o[0]=__builtin_amdgcn_mfma_f32_32x32x16_bf16(PAF(0),VFR(0),o[0],0,0,0), C0,0); \
    GAPB(o[1]=__builtin_amdgcn_mfma_f32_32x32x16_bf16(PAF(0),VFR(4),o[1],0,0,0), C0,4); \
    KRD(GL,0); GAPB(o[0]=__builtin_amdgcn_mfma_f32_32x32x16_bf16(PAF(1),VFR(1),o[0],0,0,0), C0,8); \
    KRD(GL,1); GAPB(o[1]=__builtin_amdgcn_mfma_f32_32x32x16_bf16(PAF(1),VFR(5),o[1],0,0,0), C0,12); \
    KRD(GL,2); GAPB(o[0]=__builtin_amdgcn_mfma_f32_32x32x16_bf16(PAF(2),VFR(2),o[0],0,0,0), C1,0); \
    KRD(GL,3); GAPB(o[1]=__builtin_amdgcn_mfma_f32_32x32x16_bf16(PAF(2),VFR(6),o[1],0,0,0), C1,4); \
    GAPB(o[0]=__builtin_amdgcn_mfma_f32_32x32x16_bf16(PAF(3),VFR(3),o[0],0,0,0), C1,8); \
    GAPB(o[1]=__builtin_amdgcn_mfma_f32_32x32x16_bf16(PAF(3),VFR(7),o[1],0,0,0), C1,12); \
    }while(0)
  int t=1;
  #undef CMASK
  #define CMASK(P0,P1,t) do{}while(0)
  for(;t+5<NT;t+=2){
    STEP(pB0,pB1,pA0,pA1,t,true,true,true);     WAIT_BAR(2); RESC(); ROT();
    STEP(pA0,pA1,pB0,pB1,t+1,true,true,true);   WAIT_BAR(2); RESC(); ROT();
  }
  #undef CMASK
  #define CMASK(P0,P1,t) do{int jb_=(t)-(NT-4); if(jb_>=0)cmask(P0,P1,jb_,qrel,hi);}while(0)
  #define ENDW(tt) do{ if((tt)+3<NT){WAIT_BAR(2);} else if((tt)+2<NT){WAIT_BAR(1);} else {WAIT_BAR(0);} }while(0)
  for(;t+1<NT;t+=2){
    STEP(pB0,pB1,pA0,pA1,t,(t+3<NT),(t+1<NT),(t+1<NT));       ENDW(t);   RESC(); ROT();
    STEP(pA0,pA1,pB0,pB1,t+1,(t+4<NT),(t+2<NT),(t+2<NT));     ENDW(t+1); RESC(); ROT();
  }
  STEP(pB0,pB1,pA0,pA1,NT-1,false,false,false); RESC();
  { float sacc=pB0[0]+pB0[1]; _Pragma("unroll") for(int r=2;r<16;++r)sacc+=pB0[r]; _Pragma("unroll") for(int r=0;r<16;++r)sacc+=pB1[r]; l_reg+=sacc;
    pw0=(u32x4){PKW(pB0,0),PKW(pB0,2),PKW(pB0,4),PKW(pB0,6)};pw1=(u32x4){PKW(pB0,8),PKW(pB0,10),PKW(pB0,12),PKW(pB0,14)};pw2=(u32x4){PKW(pB1,0),PKW(pB1,2),PKW(pB1,4),PKW(pB1,6)};pw3=(u32x4){PKW(pB1,8),PKW(pB1,10),PKW(pB1,12),PKW(pB1,14)};
    SBAR(); pv(o,vb0+sl_cur,PAF(0),PAF(1),PAF(2),PAF(3)); }
  #undef PKW
  #undef PAF
  #undef VFR
  #undef PIN
  #undef MX3
  #undef GAPA
  #undef GAPB
  #undef EX
  #undef VRD
  #undef KRD
  #undef STEP
  #undef ENDW
  {auto rr=__builtin_amdgcn_permlane32_swap(__float_as_uint(l_reg),__float_as_uint(l_reg),false,false);l_reg=__uint_as_float(rr[0])+__uint_as_float(rr[1]);}
  if(hi==0)wsf[32+r32]=l_reg;asm volatile("s_waitcnt lgkmcnt(0)":::"memory");
  float rli[16];
  #pragma unroll
  for(int r=0;r<16;++r)rli[r]=__builtin_amdgcn_rcpf(wsf[32+crow(r,hi)]);
  bf16*Ow=Oh+(long)(q0+wid*QBLK)*PO;
  { bf16*stg=(bf16*)(shm+LDS_OST)+wid*2048;
    #pragma unroll
    for(int r=0;r<16;++r){const int orow=crow(r,hi);
      #pragma unroll
      for(int d0=0;d0<2;++d0)stg[orow*64+d0*32+r32]=__float2bfloat16(o[d0][r]*rli[r]);}
    asm volatile("s_waitcnt lgkmcnt(0)":::"memory");
    #pragma unroll
    for(int i=0;i<4;++i){const int row=i*8+(lane>>3),ch=lane&7; const u32x4 v=*(const u32x4*)(stg+row*64+ch*8); ATTN_STORE16(Ow+(long)row*PO+ch*8,v);} }
  asm volatile("s_waitcnt lgkmcnt(0)\n\ts_barrier":::"memory");
  #undef DMA_K
  #undef DMA_V
  #undef CMASK
  #undef SETBIAS
  #undef START
  #undef RESC
  #undef ROT
}

constexpr int DV_LDS_WS=LDS_V+NSLOT*2*SLOTB, DV_LDS_OST=DV_LDS_WS+NW*64*4, DV_LDS_BYTES=DV_LDS_OST+NW*4096;
__device__ __forceinline__ void attn_unit_dv(int qb,const bf16*Qh,const bf16*__restrict__ Kh,const bf16*__restrict__ Vh,bf16*Oh,char*shm){
  int tid_=threadIdx.x; asm volatile("":"+v"(tid_)); const int tid=tid_,lane=tid&63,r32=lane&31,hi=lane>>5; const int wid=__builtin_amdgcn_readfirstlane(tid>>6);
  const int q0=qb*QB;
  const bf16*Qw=Qh+(long)(q0+wid*QBLK)*PQ;
  const unsigned lds0=(unsigned)(uintptr_t)shm;
  float*wsf=(float*)(shm+DV_LDS_WS)+wid*64;
  const bf16*ksrc=Kh+(long)lane*PQ+wid*8;
  const bf16*vsrc=Vh+(long)(16*(wid&3)+(lane>>2))*PQ+(wid>>2)*32+(lane&3)*8;
  const unsigned kdst=lds0+LDS_K+wid*1024, vdst=lds0+LDS_V+wid*1024;
  #define DMA_K(t,slot) glds16(ksrc+(long)(t)*KVBLK*PQ,(unsigned)__builtin_amdgcn_readfirstlane(kdst+(slot)))
  #define DMA_V(t,slot) do{ glds16(vsrc+(long)(t)*KVBLK*PQ,(unsigned)__builtin_amdgcn_readfirstlane(vdst+2*(slot))); glds16(vsrc+(long)SEQ*64+(long)(t)*KVBLK*PQ,(unsigned)__builtin_amdgcn_readfirstlane(vdst+2*(slot)+8192)); }while(0)
  const int vb0=(int)(lds0+LDS_V)+((lane>>4)&1)*32+(lane&3)*8+(4*hi+((lane&15)>>2))*64;
  const char*Kbase=shm+LDS_K; bf16x8 kf[8];
  const lds_cptr shm3=(lds_cptr)shm; const lds_cptr kp0=shm3+LDS_K+hi*1024+r32*16; const lds_cptr vp0=shm3+LDS_V+((lane>>4)&1)*32+(lane&3)*8+(4*hi+((lane&15)>>2))*64;
  const int NT=(q0+QB)/KVBLK;
  if(wid>=4)__builtin_amdgcn_s_setprio(1);
  DMA_K(0,0);DMA_V(0,0);DMA_K(1,SLOTB);
  bf16x8 qr[4];
  #pragma unroll
  for(int d0=0;d0<4;++d0)qr[d0]=*reinterpret_cast<const bf16x8*>(&Qw[(long)r32*PQ+d0*16+hi*8]);
  float l_reg=0.f;f32x16 o[4];o[0]=f32x16{};o[1]=f32x16{};o[2]=f32x16{};o[3]=f32x16{};const f32x16 z16=f32x16{};
  const int qrel=wid*QBLK+r32;
  #define CMASK(P0,P1,t) do{int jb_=(t)-(NT-4); if(jb_>=0)cmask(P0,P1,jb_,qrel,hi);}while(0)
  f32x16 pA0,pA1;
  int sl_prev=0,sl_cur=0,sl_next=SLOTB;
  #define ROT() do{sl_prev=sl_cur;sl_cur=sl_next;sl_next=(sl_next==(NSLOT-1)*SLOTB)?0:sl_next+SLOTB;}while(0)
  u32x4 pw0,pw1,pw2,pw3;
  #define PKW(P,B) cvtpk_s(P[B],P[B+1])
  #define PAF(k) __builtin_bit_cast(bf16x8,pw##k)
  #define PIN(x) asm volatile("":"+v"(x))
  #define EX(v) __builtin_amdgcn_exp2f(v)
  #define PACKP(P0,P1) do{ float sa_=(P0[0]+P0[1])+(P0[2]+P0[3]), sb_=(P1[0]+P1[1])+(P1[2]+P1[3]); \
    _Pragma("unroll") for(int r_=4;r_<16;r_+=4){ sa_+=(P0[r_]+P0[r_+1])+(P0[r_+2]+P0[r_+3]); sb_+=(P1[r_]+P1[r_+1])+(P1[r_+2]+P1[r_+3]); } l_reg+=sa_+sb_; \
    pw0=(u32x4){PKW(P0,0),PKW(P0,2),PKW(P0,4),PKW(P0,6)};pw1=(u32x4){PKW(P0,8),PKW(P0,10),PKW(P0,12),PKW(P0,14)};pw2=(u32x4){PKW(P1,0),PKW(P1,2),PKW(P1,4),PKW(P1,6)};pw3=(u32x4){PKW(P1,8),PKW(P1,10),PKW(P1,12),PKW(P1,14)}; PIN(pw0);PIN(pw1);PIN(pw2);PIN(pw3);PIN(l_reg); }while(0)
  DMA_K(2,2*SLOTB);
  WAIT_BAR(3);
  qkt(pA0,pA1,Kbase,qr,z16,r32,hi);CMASK(pA0,pA1,0);
  _Pragma("unroll") for(int r=0;r<16;++r){pA0[r]=EX(pA0[r]);pA1[r]=EX(pA1[r]);}
  PACKP(pA0,pA1);
  WAIT_BAR(0);
  DMA_K(3,0);DMA_V(1,SLOTB);
  ROT();
  kload8(kf,kp0+sl_cur);
  WAIT_BAR(3);
  s16x4 valo[2][4],vahi[2][4];
  #define VLD1(buf,ks,db) do{ valo[buf][db]=vtr(vp_+((db)*4096+(ks)*1024)); vahi[buf][db]=vtr(vp_+((db)*4096+(ks)*1024+512)); }while(0)
  #define VF(buf,db) (bf16x8){valo[buf][db][0],valo[buf][db][1],valo[buf][db][2],valo[buf][db][3],vahi[buf][db][0],vahi[buf][db][1],vahi[buf][db][2],vahi[buf][db][3]}
  #define KRD(G,j) do{ if(G){ kload2(kf,kp0+sl_next,j); SBAR(); } }while(0)
  #define QK(C,kk,qq,Cin) do{ C=__builtin_amdgcn_mfma_f32_32x32x16_bf16(kf[kk],qr[qq],Cin,0,0,0); SBAR(); }while(0)
  #define MFO(db,ks,buf) o[db]=__builtin_amdgcn_mfma_f32_32x32x16_bf16(PAF(ks),VF(buf,db),o[db],0,0,0)
  #define G4(ks,buf,X,B,DOPREV,PX,PB,PWP) do{ \
    MFO(0,ks,buf); X[B]=EX(X[B]); X[B+1]=EX(X[B+1]); if(DOPREV){ sacc+=PX[PB]; sacc+=PX[PB+1]; PWP[0]=PKW(PX,PB); } PIN(X); SBAR(); \
    MFO(1,ks,buf); X[B+2]=EX(X[B+2]); X[B+3]=EX(X[B+3]); if(DOPREV){ sacc+=PX[PB+2]; sacc+=PX[PB+3]; PWP[1]=PKW(PX,PB+2); } PIN(X); SBAR(); \
    MFO(2,ks,buf); X[B+4]=EX(X[B+4]); X[B+5]=EX(X[B+5]); if(DOPREV){ sacc+=PX[PB+4]; sacc+=PX[PB+5]; PWP[2]=PKW(PX,PB+4); } PIN(X); SBAR(); \
    MFO(3,ks,buf); X[B+6]=EX(X[B+6]); X[B+7]=EX(X[B+7]); if(DOPREV){ sacc+=PX[PB+6]; sacc+=PX[PB+7]; PWP[3]=PKW(PX,PB+6); PIN(PWP); } PIN(X); PIN(sacc); SBAR(); \
    }while(0)
  #define STEP(C0,C1,t,GK,GV,GL) do{ SBAR(); \
    const lds_cptr vp_=vp0+2*sl_prev; float sacc=0.f; \
    VLD1(0,0,0); SBAR(); QK(C0,0,0,z16); \
    VLD1(0,0,1); SBAR(); QK(C1,1,0,z16); \
    VLD1(0,0,2); SBAR(); QK(C0,2,1,C0); \
    VLD1(0,0,3); SBAR(); QK(C1,3,1,C1); \
    VLD1(1,1,0); SBAR(); QK(C0,4,2,C0); \
    VLD1(1,1,1); SBAR(); QK(C1,5,2,C1); \
    VLD1(1,1,2); SBAR(); QK(C0,6,3,C0); \
    VLD1(1,1,3); SBAR(); QK(C1,7,3,C1); \
    if(GK){DMA_K((t)+3,sl_cur);} if(GV){DMA_V((t)+1,sl_next);} \
    CMASK(C0,C1,t); \
    SBAR(); \
    G4(0,0,C0,0,false,C0,0,pw0); \
    VLD1(0,2,0); VLD1(0,2,1); VLD1(0,2,2); VLD1(0,2,3); SBAR(); KRD(GL,0); KRD(GL,1); \
    G4(1,1,C0,8,true,C0,0,pw0); \
    VLD1(1,3,0); VLD1(1,3,1); VLD1(1,3,2); VLD1(1,3,3); SBAR(); KRD(GL,2); KRD(GL,3); \
    G4(2,0,C1,0,true,C0,8,pw1); \
    G4(3,1,C1,8,true,C1,0,pw2); \
    sacc+=(C1[8]+C1[9])+(C1[10]+C1[11]); sacc+=(C1[12]+C1[13])+(C1[14]+C1[15]); l_reg+=sacc; \
    pw3=(u32x4){PKW(C1,8),PKW(C1,10),PKW(C1,12),PKW(C1,14)}; PIN(pw3); PIN(l_reg); PIN(o[0]);PIN(o[1]);PIN(o[2]);PIN(o[3]); SBAR(); \
    }while(0)
  int t=1;
  #undef CMASK
  #define CMASK(P0,P1,t) do{}while(0)
  for(;t+5<NT;t+=2){
    STEP(pA0,pA1,t,true,true,true);     WAIT_BAR(3); ROT();
    STEP(pA0,pA1,t+1,true,true,true);   WAIT_BAR(3); ROT();
  }
  #undef CMASK
  #define CMASK(P0,P1,t) do{int jb_=(t)-(NT-4); if(jb_>=0)cmask(P0,P1,jb_,qrel,hi);}while(0)
  #define ENDW(tt) do{ if((tt)+3<NT){WAIT_BAR(3);} else if((tt)+2<NT){WAIT_BAR(2);} else {WAIT_BAR(0);} }while(0)
  for(;t+1<NT;t+=2){
    STEP(pA0,pA1,t,(t+3<NT),(t+1<NT),(t+1<NT));       ENDW(t);   ROT();
    STEP(pA0,pA1,t+1,(t+4<NT),(t+2<NT),(t+2<NT));     ENDW(t+1); ROT();
  }
  STEP(pA0,pA1,NT-1,false,false,false);
  SBAR(); pv2(o[0],o[1],vb0+2*sl_cur,PAF(0),PAF(1),PAF(2),PAF(3)); pv2(o[2],o[3],vb0+2*sl_cur+8192,PAF(0),PAF(1),PAF(2),PAF(3));
  #undef PKW
  #undef PAF
  #undef PIN
  #undef EX
  #undef VLD1
  #undef VF
  #undef MFO
  #undef G4
  #undef KRD
  #undef QK
  #undef STEP
  #undef ENDW
  #undef PACKP
  {auto rr=__builtin_amdgcn_permlane32_swap(__float_as_uint(l_reg),__float_as_uint(l_reg),false,false);l_reg=__uint_as_float(rr[0])+__uint_as_float(rr[1]);}
  if(hi==0)wsf[32+r32]=l_reg;asm volatile("s_waitcnt lgkmcnt(0)":::"memory");
  float rli[16];
  #pragma unroll
  for(int r=0;r<16;++r)rli[r]=__builtin_amdgcn_rcpf(wsf[32+crow(r,hi)]);
  bf16*Ow=Oh+(long)(q0+wid*QBLK)*PO;
  { bf16*stg=(bf16*)(shm+DV_LDS_OST)+wid*2048;
    #pragma unroll
    for(int hh=0;hh<2;++hh){
      #pragma unroll
      for(int r=0;r<16;++r){const int orow=crow(r,hi);
        #pragma unroll
        for(int d0=0;d0<2;++d0)stg[orow*64+d0*32+r32]=__float2bfloat16(o[2*hh+d0][r]*rli[r]);}
      asm volatile("s_waitcnt lgkmcnt(0)":::"memory");
      #pragma unroll
      for(int i=0;i<4;++i){const int row=i*8+(lane>>3),ch=lane&7; const u32x4 v=*(const u32x4*)(stg+row*64+ch*8); ATTN_STORE16(Ow+(long)row*PO+hh*64+ch*8,v);}
      asm volatile("s_waitcnt lgkmcnt(0)":::"memory"); } }
  __builtin_amdgcn_s_setprio(0);
  asm volatile("s_waitcnt lgkmcnt(0)\n\ts_barrier":::"memory");
  #undef DMA_K
  #undef DMA_V
  #undef CMASK
  #undef ROT
}

__device__ __forceinline__ void pv2c(f32x16&oa,f32x16&ob,lds_cptr vb,bf16x8 pa0,bf16x8 pa1,bf16x8 pa2,bf16x8 pa3){
  #pragma unroll
  for(int d0=0;d0<2;++d0){ s16x4 lo[4],hi[4];
    #pragma unroll
    for(int ks=0;ks<4;++ks){ lo[ks]=vtr(vb+(d0*4096+ks*1024)); hi[ks]=vtr(vb+(d0*4096+ks*1024+512)); }
    #define PK(k) (bf16x8){lo[k][0],lo[k][1],lo[k][2],lo[k][3],hi[k][0],hi[k][1],hi[k][2],hi[k][3]}
    f32x16 acc=d0?ob:oa;
    acc=__builtin_amdgcn_mfma_f32_32x32x16_bf16(pa0,PK(0),acc,0,0,0);
    acc=__builtin_amdgcn_mfma_f32_32x32x16_bf16(pa1,PK(1),acc,0,0,0);
    acc=__builtin_amdgcn_mfma_f32_32x32x16_bf16(pa2,PK(2),acc,0,0,0);
    acc=__builtin_amdgcn_mfma_f32_32x32x16_bf16(pa3,PK(3),acc,0,0,0);
    if(d0)ob=acc;else oa=acc;
    #undef PK
  }
}
constexpr int MB_K=0, MB_V=32768, MB_WS=65536, MB_OST=MB_WS+NW*256, MB_END=MB_OST+NW*4096;
__device__ __forceinline__ void moba_load_block(const bf16*Kb,const bf16*Vb,char*shm){
  int tid_=threadIdx.x; asm volatile("":"+v"(tid_)); const int lane=tid_&63; const int wid=__builtin_amdgcn_readfirstlane(tid_>>6);
  const unsigned lds0=(unsigned)(uintptr_t)shm;
  const bf16*ksrc=Kb+(long)lane*PQ+wid*8;
  const bf16*vsrc=Vb+(long)(16*(wid&3)+(lane>>2))*PQ+(wid>>2)*32+(lane&3)*8;
  #pragma unroll
  for(int t=0;t<4;++t){ glds16(ksrc+(long)t*KVBLK*PQ,(unsigned)__builtin_amdgcn_readfirstlane(lds0+MB_K+t*8192+wid*1024)); glds16(vsrc+(long)t*KVBLK*PQ,(unsigned)__builtin_amdgcn_readfirstlane(lds0+MB_V+t*8192+wid*1024)); }
  asm volatile("s_waitcnt vmcnt(0) lgkmcnt(0)\n\ts_barrier":::"memory");
}
struct MobaQ { bf16x8 f[4]; };
__device__ __forceinline__ MobaQ moba_qload(const bf16*Qh,int q){ int tid_=threadIdx.x; asm volatile("":"+v"(tid_)); const int hi=(tid_&63)>>5; MobaQ r;
  #pragma unroll
  for(int d0=0;d0<4;++d0)r.f[d0]=*reinterpret_cast<const bf16x8*>(&Qh[(long)q*PQ+d0*16+hi*8]); return r; }
template<bool CAUSAL> __device__ __forceinline__ void moba_task(const MobaQ&Q,int qrel,char*shm){
  int tid_=threadIdx.x; asm volatile("":"+v"(tid_)); const int lane=tid_&63,r32=lane&31,hi=lane>>5; const int wid=__builtin_amdgcn_readfirstlane(tid_>>6);
  const unsigned lds0=(unsigned)(uintptr_t)shm;
  float*wsf=(float*)(shm+MB_WS)+wid*64;
  const lds_cptr vb0=(lds_cptr)shm+MB_V+((lane>>4)&1)*32+(lane&3)*8+(4*hi+((lane&15)>>2))*64;
  f32x16 o[2];o[0]=f32x16{};o[1]=f32x16{};float l_reg=0.f;const f32x16 z16=f32x16{};
  #pragma unroll
  for(int t=0;t<4;++t){
    const int wrow0=__builtin_amdgcn_readfirstlane(qrel)&~31;
    if(CAUSAL&&t*64>wrow0+31)continue;
    f32x16 p0,p1;
    qkt(p0,p1,shm+MB_K+t*8192,Q.f,z16,r32,hi);
    if(CAUSAL&&t*64+63>wrow0)cmask(p0,p1,t,qrel,hi);
    #pragma unroll
    for(int r=0;r<16;++r){p0[r]=__builtin_amdgcn_exp2f(p0[r]);p1[r]=__builtin_amdgcn_exp2f(p1[r]);}
    float sa=(p0[0]+p0[1])+(p0[2]+p0[3]),sb=(p1[0]+p1[1])+(p1[2]+p1[3]);
    #pragma unroll
    for(int r=4;r<16;r+=4){sa+=(p0[r]+p0[r+1])+(p0[r+2]+p0[r+3]);sb+=(p1[r]+p1[r+1])+(p1[r+2]+p1[r+3]);}
    l_reg+=sa+sb;
    const u32x4 w0={cvtpk_s(p0[0],p0[1]),cvtpk_s(p0[2],p0[3]),cvtpk_s(p0[4],p0[5]),cvtpk_s(p0[6],p0[7])},w1={cvtpk_s(p0[8],p0[9]),cvtpk_s(p0[10],p0[11]),cvtpk_s(p0[12],p0[13]),cvtpk_s(p0[14],p0[15])};
    const u32x4 w2={cvtpk_s(p1[0],p1[1]),cvtpk_s(p1[2],p1[3]),cvtpk_s(p1[4],p1[5]),cvtpk_s(p1[6],p1[7])},w3={cvtpk_s(p1[8],p1[9]),cvtpk_s(p1[10],p1[11]),cvtpk_s(p1[12],p1[13]),cvtpk_s(p1[14],p1[15])};
    pv2c(o[0],o[1],vb0+t*8192,__builtin_bit_cast(bf16x8,w0),__builtin_bit_cast(bf16x8,w1),__builtin_bit_cast(bf16x8,w2),__builtin_bit_cast(bf16x8,w3));
  }
  {auto rr=__builtin_amdgcn_permlane32_swap(__float_as_uint(l_reg),__float_as_uint(l_reg),false,false);l_reg=__uint_as_float(rr[0])+__uint_as_float(rr[1]);}
  if(hi==0)wsf[32+r32]=l_reg;asm volatile("s_waitcnt lgkmcnt(0)":::"memory");
  float rli[16];
  #pragma unroll
  for(int r=0;r<16;++r)rli[r]=__builtin_amdgcn_rcpf(wsf[32+crow(r,hi)]);
  bf16*stg=(bf16*)(shm+MB_OST)+wid*2048;
  #pragma unroll
  for(int r=0;r<16;++r){const int orow=crow(r,hi);
    #pragma unroll
    for(int d0=0;d0<2;++d0)stg[orow*64+d0*32+r32]=__float2bfloat16(o[d0][r]*rli[r]);}
  asm volatile("s_waitcnt lgkmcnt(0)":::"memory");
}
constexpr int ATTN_LDS_BYTES=LDS_BYTES;
#undef SBAR
#undef WAIT_BAR
}
#include <hip/hip_cooperative_groups.h>
namespace cg = cooperative_groups;
constexpr int NWAVES = 8;
constexpr int BATCH = 4, SEQ = 8192, DM = 1024, M = BATCH * SEQ, NPROJ = 3072, FFN = 2816, NGU = 2 * FFN;
constexpr size_t MiB = 1u << 20;
constexpr size_t WS_WIN = 0, WS_WOUT = 6 * MiB, WS_WGU = 8 * MiB, WS_WDN = 19 * MiB;
constexpr size_t WS_ROPE = 25 * MiB;
constexpr size_t WS_KMEAN = 27 * MiB;
constexpr size_t WS_GTAB = 27 * MiB + 512 * 1024;
constexpr size_t WS_BAR = 31 * MiB;
constexpr size_t WS_SS = 28 * MiB;
constexpr size_t WS_XN = 32 * MiB;
constexpr size_t WS_QKV = 96 * MiB;
constexpr size_t WS_OST = 288 * MiB;
constexpr size_t WS_MIX = 352 * MiB;
constexpr size_t WS_GL = 32 * MiB;
constexpr size_t WS_GC = 48 * MiB;
constexpr size_t WS_LP = 49 * MiB;
constexpr size_t WS_OP = 416 * MiB;
constexpr size_t WS_END = 512 * MiB;
constexpr int RING_BYTES = 131072, KM_OFF = 86016, LDS_BYTES = 147456;
#define GAS __attribute__((address_space(1)))
#define LAS __attribute__((address_space(3)))
typedef unsigned short bf16;
typedef unsigned v4u __attribute__((ext_vector_type(4)));
typedef float f32x4 __attribute__((ext_vector_type(4)));
#define LDS_WAIT() asm volatile("s_waitcnt lgkmcnt(0)" ::: "memory")
#define XB_TMO      128
#define XB_XCNT(j)  (256  + 64 * (j))
#define XB_XSUB(j)  (1280 + 64 * (j))
#define XB_XGEN(j)  (2304 + 64 * (j))
#define XB_TOP      3328
#define XB_TOPGEN   3392
#define XCD_BAR_WORDS 3456
#define XB_SPIN_CAP (1u << 18)

__device__ __forceinline__ unsigned xb_ld(unsigned* p)              { return __hip_atomic_load(p, __ATOMIC_RELAXED, __HIP_MEMORY_SCOPE_AGENT); }
__device__ __forceinline__ unsigned xb_add(unsigned* p, unsigned v) { return __hip_atomic_fetch_add(p, v, __ATOMIC_RELAXED, __HIP_MEMORY_SCOPE_AGENT); }
__device__ __forceinline__ unsigned xb_xcc_id() { return (unsigned)__builtin_amdgcn_s_getreg((3 << 11) | 20) & 0xFu; }
#define XB_SPIN(cond, bar) do { unsigned _sp = 0; while (cond) { __builtin_amdgcn_s_sleep(1); \
    if ((++_sp & 255u) == 0u) { if (xb_ld(&(bar)[XB_TMO])) break; if (_sp > XB_SPIN_CAP) { atomicAdd(&(bar)[XB_TMO], 1u); break; } } } } while (0)

struct XcdBarrier {
    unsigned* bar; unsigned x;
    volatile LAS unsigned* st;
};

__device__ __forceinline__ XcdBarrier xcd_barrier_post(unsigned* bar, volatile LAS unsigned* st) {
    XcdBarrier b; b.bar = bar; b.x = xb_xcc_id(); b.st = st;
    if (threadIdx.x == 0) (void)xb_add(&bar[XB_XCNT(b.x)], 1u);
    return b;
}
__device__ __forceinline__ void xcd_barrier_complete(unsigned* bar, unsigned x, unsigned& nloc, unsigned& nx) {
    const unsigned G = gridDim.x * gridDim.y * gridDim.z;
    unsigned sum, cnt, mine, sp = 0u;
    for (;;) {
        sum = 0u; cnt = 0u; mine = 0u;
#pragma unroll
        for (unsigned j = 0; j < 16; ++j) { const unsigned c = xb_ld(&bar[XB_XCNT(j)]); sum += c; cnt += (c > 0u) ? 1u : 0u; mine = (j == x) ? c : mine; }
        if (sum == G) break;
        __builtin_amdgcn_s_sleep(1);
        if ((++sp & 255u) == 0u) { if (xb_ld(&bar[XB_TMO])) break; if (sp > XB_SPIN_CAP) { atomicAdd(&bar[XB_TMO], 1u); break; } }
    }
    nloc = mine > 0u ? mine : 1u; nx = cnt > 0u ? cnt : 1u;
}

__device__ __forceinline__ void xcd_barrier(const XcdBarrier& b) {
    asm volatile("s_waitcnt vmcnt(0)" ::: "memory");
    __syncthreads();
    if (threadIdx.x == 0) {
        unsigned* bar = b.bar;
        __builtin_amdgcn_s_waitcnt(0);
        unsigned nloc = b.st[0], nx = b.st[1];
        if (nloc == 0u) { xcd_barrier_complete(bar, b.x, nloc, nx); b.st[0] = nloc; b.st[1] = nx; }
        const unsigned old = xb_add(&bar[XB_XSUB(b.x)], 1u);
        const unsigned gen = old / nloc;
        if (old + 1u == (gen + 1u) * nloc) {
            __builtin_amdgcn_fence(__ATOMIC_RELEASE, "agent");
            asm volatile("s_waitcnt vmcnt(0)" ::: "memory");
            const unsigned og = xb_add(&bar[XB_TOP], 1u);
            const unsigned tg = og / nx;
            if (og + 1u == (tg + 1u) * nx) xb_add(&bar[XB_TOPGEN], 1u);
            else XB_SPIN(xb_ld(&bar[XB_TOPGEN]) == tg, bar);
            __builtin_amdgcn_fence(__ATOMIC_ACQUIRE, "agent");
            xb_add(&bar[XB_XGEN(b.x)], 1u);
            asm volatile("s_waitcnt vmcnt(0)" ::: "memory");
        } else {
            XB_SPIN(xb_ld(&bar[XB_XGEN(b.x)]) == gen, bar);
            __builtin_amdgcn_fence(__ATOMIC_ACQUIRE, "agent");
            asm volatile("s_waitcnt vmcnt(0)" ::: "memory");
        }
    }
    __syncthreads();
}

__device__ __forceinline__ unsigned f2bf(float f) { unsigned u = __builtin_bit_cast(unsigned, f); return (u + 0x7fffu + ((u >> 16) & 1u)) >> 16; }
__device__ __forceinline__ unsigned pk2(float lo, float hi) { return f2bf(lo) | (f2bf(hi) << 16); }
__device__ __forceinline__ float bf_lo(unsigned w) { return __builtin_bit_cast(float, w << 16); }
__device__ __forceinline__ float bf_hi(unsigned w) { return __builtin_bit_cast(float, w & 0xffff0000u); }
__device__ __forceinline__ float wave_sum(float v) {
#pragma unroll
    for (int o = 1; o < 64; o <<= 1) v += __shfl_xor(v, o);
    return v;
}
__constant__ double ROPE_REV[32] = {
0.15915494309189535,
0.11934937021124886,
0.08949940160889101,
0.06711508300522726,
0.050329212104487035,
0.03774158471741977,
0.0283021958306234,
0.02122365276477766,
0.015915494309189534,
0.011934937021124886,
0.008949940160889102,
0.006711508300522725,
0.005032921210448704,
0.003774158471741977,
0.00283021958306234,
0.0021223652764777662,
0.0015915494309189536,
0.0011934937021124885,
0.0008949940160889102,
0.0006711508300522726,
0.0005032921210448703,
0.00037741584717419774,
0.00028302195830623395,
0.0002122365276477766,
0.00015915494309189535,
0.00011934937021124886,
8.949940160889102e-05,
6.711508300522725e-05,
5.0329212104487035e-05,
3.774158471741978e-05,
2.8302195830623396e-05,
2.122365276477766e-05
};
__device__ __forceinline__ void p0_transpose_item(const float* W, int K, int N, bf16* WT, int mode, const float* gain, LAS float* scr, int item, int lane) {
    const int nblk = N / 32, kb = item / nblk, nb = item % nblk, k0 = 64 * kb, n0 = 32 * nb;
    int dst;
    if (mode == 0) dst = n0;
    else if (mode == 1) { const int pn = n0 >> 8, r = n0 & 255; dst = pn * 256 + ((r >> 5) & 1) * 128 + (r >> 6) * 32; }
    else { const int pn = n0 >> 7, q0 = n0 & 127; dst = pn * 256 + (mode == 3 ? 128 : 0) + q0; }
    float wv[32];
#pragma unroll
    for (int i = 0; i < 32; ++i) { const int kk = 2 * i + (lane >> 5); wv[i] = __builtin_nontemporal_load(W + (size_t)(k0 + kk) * N + n0 + (lane & 31)); }
#pragma unroll
    for (int i = 0; i < 32; ++i) { const int kk = 2 * i + (lane >> 5); float w = wv[i]; if (gain) w *= gain[k0 + kk]; scr[kk * 33 + (lane & 31)] = w; }
    LDS_WAIT(); asm volatile("" ::: "memory");
    const int c = lane & 7;
#pragma unroll
    for (int j = 0; j < 4; ++j) { const int n = (lane >> 3) + 8 * j; const LAS float* s = scr + (8 * c) * 33 + n;
        v4u o; o.x = pk2(s[0 * 33], s[1 * 33]); o.y = pk2(s[2 * 33], s[3 * 33]); o.z = pk2(s[4 * 33], s[5 * 33]); o.w = pk2(s[6 * 33], s[7 * 33]);
        *(GAS v4u*)(WT + (size_t)(dst + n) * K + k0 + 8 * c) = o; }
    LDS_WAIT(); asm volatile("" ::: "memory");
}
#ifndef REP_G1
#define REP_G1 1
#endif
#ifndef REP_X
#define REP_X 1
#endif
#ifndef REP_Y
#define REP_Y 1
#endif
struct Args { const float* in[17]; float* out; unsigned char* ws; };
enum { I_X = 0, I_ATTN_NORM, I_W_IN, I_MQN, I_MKN, I_DQN, I_DKN, I_LQ1, I_LK1, I_LQ2, I_LK2, I_SUBLN, I_W_OUT, I_FFN_NORM, I_W_GATE, I_W_UP, I_W_DOWN };

__global__ void __launch_bounds__(NWAVES * 64, 2) hymba_fwd(Args args) {
    extern __shared__ __attribute__((aligned(16))) unsigned char lds[];
    cg::grid_group grid = cg::this_grid();
    volatile __attribute__((address_space(3))) unsigned* const xb_st = (volatile __attribute__((address_space(3))) unsigned*)((__attribute__((address_space(3))) unsigned char*)lds + 131072 + 64);
    if (threadIdx.x < 2) xb_st[threadIdx.x] = 0u;
    __syncthreads();
    const XcdBarrier xbar = xcd_barrier_post((unsigned*)(args.ws + WS_BAR), xb_st);
    LAS unsigned char* const ldsl = (LAS unsigned char*)lds;
    const int tid = threadIdx.x, lane = tid & 63, wave = __builtin_amdgcn_readfirstlane(tid >> 6);
    const int G = gridDim.x; const int bx = blockIdx.x;
    const int vcu = (G % 8 == 0) ? (bx % 8) * (G / 8) + bx / 8 : bx;
    unsigned char* const ws = args.ws;
    bf16* const Win_t = (bf16*)(ws + WS_WIN); bf16* const Wout_t = (bf16*)(ws + WS_WOUT); bf16* const Wgu_t = (bf16*)(ws + WS_WGU); bf16* const Wdn_t = (bf16*)(ws + WS_WDN);
    float* const rcos = (float*)(ws + WS_ROPE); float* const rsin = rcos + 8192 * 32;
    float* const gtab = (float*)(ws + WS_GTAB); float* const kmean = (float*)(ws + WS_KMEAN); float* const SS = (float*)(ws + WS_SS);
    bf16* const XN = (bf16*)(ws + WS_XN); bf16* const QKV = (bf16*)(ws + WS_QKV); bf16* const HB = (bf16*)(ws + WS_QKV);
    bf16* const OST = (bf16*)(ws + WS_OST); bf16* const MIX = (bf16*)(ws + WS_MIX);
    unsigned short* const GL = (unsigned short*)(ws + WS_GL); unsigned* const GC = (unsigned*)(ws + WS_GC); float* const LP = (float*)(ws + WS_LP); bf16* const OP = (bf16*)(ws + WS_OP);
    const float* const x = args.in[I_X]; float* const out = args.out;

    {
        LAS float* scr = (LAS float*)(ldsl + wave * 16384);
        const int gw = vcu * NWAVES + wave, NGW = G * NWAVES;
        constexpr int I_IN = (DM / 64) * (NPROJ / 32), I_OUT = (DM / 64) * (DM / 32), I_G = (DM / 64) * (FFN / 32), I_D = (FFN / 64) * (DM / 32);
        constexpr int NITEMS = I_IN + I_OUT + 2 * I_G + I_D;
        for (int it = gw; it < NITEMS; it += NGW) {
            int r = it;
            if (r < I_IN) { p0_transpose_item(args.in[I_W_IN], DM, NPROJ, Win_t, 1, nullptr, scr, r, lane); continue; } r -= I_IN;
            if (r < I_OUT) { p0_transpose_item(args.in[I_W_OUT], DM, DM, Wout_t, 0, nullptr, scr, r, lane); continue; } r -= I_OUT;
            if (r < I_G) { p0_transpose_item(args.in[I_W_GATE], DM, FFN, Wgu_t, 2, args.in[I_FFN_NORM], scr, r, lane); continue; } r -= I_G;
            if (r < I_G) { p0_transpose_item(args.in[I_W_UP], DM, FFN, Wgu_t, 3, args.in[I_FFN_NORM], scr, r, lane); continue; } r -= I_G;
            p0_transpose_item(args.in[I_W_DOWN], FFN, DM, Wdn_t, 0, nullptr, scr, r, lane);
        }
        const GAS f32x4* gp = (const GAS f32x4*)args.in[I_ATTN_NORM] + lane;
        f32x4 gn[4];
#pragma unroll
        for (int j = 0; j < 4; ++j) gn[j] = gp[64 * j];
        for (int m0 = gw; m0 < M; m0 += 2 * NGW) {
            const int m1 = (m0 + NGW < M) ? m0 + NGW : m0;
            const GAS f32x4* xr0 = (const GAS f32x4*)(x + (size_t)m0 * DM) + lane; const GAS f32x4* xr1 = (const GAS f32x4*)(x + (size_t)m1 * DM) + lane;
            f32x4 v0[4], v1[4]; float s0 = 0.f, s1 = 0.f;
#pragma unroll
            for (int j = 0; j < 4; ++j) { v0[j] = __builtin_nontemporal_load(xr0 + 64 * j); v1[j] = __builtin_nontemporal_load(xr1 + 64 * j); }
#pragma unroll
            for (int j = 0; j < 4; ++j) { s0 += (v0[j].x * v0[j].x + v0[j].y * v0[j].y) + (v0[j].z * v0[j].z + v0[j].w * v0[j].w); s1 += (v1[j].x * v1[j].x + v1[j].y * v1[j].y) + (v1[j].z * v1[j].z + v1[j].w * v1[j].w); }
#pragma unroll
            for (int o = 1; o < 64; o <<= 1) { s0 += __shfl_xor(s0, o); s1 += __shfl_xor(s1, o); }
            const float r0 = __builtin_amdgcn_rsqf(s0 * (1.f / DM) + 1e-6f), r1 = __builtin_amdgcn_rsqf(s1 * (1.f / DM) + 1e-6f);
            GAS unsigned long long* o0 = (GAS unsigned long long*)(XN + (size_t)m0 * DM) + lane; GAS unsigned long long* o1 = (GAS unsigned long long*)(XN + (size_t)m1 * DM) + lane;
#pragma unroll
            for (int j = 0; j < 4; ++j) { const f32x4 w0 = v0[j] * r0 * gn[j], w1 = v1[j] * r1 * gn[j];
                o0[64 * j] = (unsigned long long)pk2(w0.x, w0.y) | ((unsigned long long)pk2(w0.z, w0.w) << 32); o1[64 * j] = (unsigned long long)pk2(w1.x, w1.y) | ((unsigned long long)pk2(w1.z, w1.w) << 32); }
        }
        if (bx == 0) {
            if (tid < 64) gtab[tid] = args.in[I_MQN][tid];
            else if (tid < 128) gtab[tid] = args.in[I_MKN][tid - 64];
            else if (tid < 192) gtab[tid + 64] = args.in[I_DQN][tid - 128];
            else if (tid < 256) gtab[tid + 64] = args.in[I_DKN][tid - 192];
        }
        for (int e = bx * (NWAVES * 64) + tid; e < 8192 * 32; e += G * NWAVES * 64) {
            const int pos = e >> 5, i = e & 31;
            const double rev = (double)pos * ROPE_REV[i]; const float fr = (float)(rev - __builtin_rint(rev));
            rcos[e] = __builtin_amdgcn_cosf(fr); rsin[e] = __builtin_amdgcn_sinf(fr);
        }
    }
    if (gridDim.y == 0x7fffu) grid.sync();
    xcd_barrier(xbar);
    {
        pg8::Gemm g{XN, Win_t, M, NPROJ, DM}; pg8::StaticOrder S; S.init(M, NPROJ, G, bx);
        pg8::EpiQKV E{QKV, gtab, rcos, rsin, attn_body::C2, kmean};
        pg8::gemm_phase<pg8::EpiQKV, pg8::StaticOrder, PG8_ALIGN, PG8_SP2>(ldsl, g, S, E);
    }
    xcd_barrier(xbar);
    {
        const int r32 = lane & 31, hi = lane >> 5;
        for (int rep_ = 0; rep_ < REP_G1; ++rep_) {
#define G1_DECODE(U0, BH, QB) const int BH = (U0) >> 5, QB = (((U0) & 31) + 8 * ((U0) >> 8)) & 31
#define G1_LOADS(U0) do { if ((U0) < BATCH * 8 * 32) { G1_DECODE(U0, bh_, qb_); const float* kp_ = kmean + ((size_t)(bh_ * 32 + (tid >> 4)) * 2) * 64 + (tid & 15) * 4; pka = *(const GAS f32x4*)kp_; pkb = *(const GAS f32x4*)(kp_ + 64); \
            const bf16* qp_ = QKV + ((size_t)((bh_ >> 3) * 48 + (bh_ & 7)) * SEQ + qb_ * 256 + wave * 32 + r32) * 64 + hi * 8; _Pragma("unroll") for (int c_ = 0; c_ < 4; ++c_) pqw[c_] = *(const GAS v4u*)(qp_ + c_ * 16); } } while (0)
        f32x4 pka, pkb; v4u pqw[4];
        G1_LOADS(vcu);
        int par = 0, pbh = -1, pqb = 0;
        for (int u0 = vcu; u0 < BATCH * 8 * 32; u0 += G, par ^= 1) {
            G1_DECODE(u0, bh, qb); const int u = bh * 32 + qb;
            LAS unsigned char* kmh = ldsl + par * 16384; LAS unsigned char* kml = kmh + 8192;
            LAS unsigned* cnt = (LAS unsigned*)(ldsl + 32768 + par * 128); LAS unsigned* pcnt = (LAS unsigned*)(ldsl + 32768 + (par ^ 1) * 128);
            if (tid < 32) cnt[tid] = 0u;
            { const f32x4 m4 = (pka + pkb) * (1.0f / 256.0f);
              const int n_ = tid >> 4, d_ = (tid & 15) * 4; const unsigned off = (unsigned)((d_ >> 3) * 1024 + n_ * 16 + (d_ & 7) * 2);
              unsigned hw[4]; float lf[4];
#pragma unroll
              for (int e = 0; e < 4; ++e) { hw[e] = f2bf(m4[e]); lf[e] = m4[e] - __builtin_bit_cast(float, hw[e] << 16); }
              *(LAS unsigned long long*)(kmh + off) = (unsigned long long)(hw[0] | (hw[1] << 16)) | ((unsigned long long)(hw[2] | (hw[3] << 16)) << 32);
              *(LAS unsigned long long*)(kml + off) = (unsigned long long)pk2(lf[0], lf[1]) | ((unsigned long long)pk2(lf[2], lf[3]) << 32); }
            attn_body::bf16x8 qf[4];
#pragma unroll
            for (int c = 0; c < 4; ++c) qf[c] = __builtin_bit_cast(attn_body::bf16x8, pqw[c]);
            G1_LOADS(u0 + G);
            __syncthreads();
            if (pbh >= 0 && tid < 32) GC[(pbh * 32 + tid) * 32 + pqb] = pcnt[tid];
            pbh = bh; pqb = qb;
            attn_body::f32x16 gt = {};
#pragma unroll
            for (int d0 = 0; d0 < 4; ++d0) {
                const attn_body::bf16x8 kh_ = *(const LAS attn_body::bf16x8*)(kmh + hi * 1024 + r32 * 16 + d0 * 2048), kl_ = *(const LAS attn_body::bf16x8*)(kml + hi * 1024 + r32 * 16 + d0 * 2048);
                gt = __builtin_amdgcn_mfma_f32_32x32x16_bf16(kh_, qf[d0], gt, 0, 0, 0); gt = __builtin_amdgcn_mfma_f32_32x32x16_bf16(kl_, qf[d0], gt, 0, 0, 0); }
            float v1 = -INFINITY, v2 = -INFINITY, v3 = -INFINITY; int i1 = 0, i2 = 0, i3 = 0;
#pragma unroll
            for (int r = 0; r < 16; ++r) { const int n = (r & 3) + 8 * (r >> 2) + 4 * hi; const float p = n < qb ? gt[r] : -INFINITY;
                const bool g1 = p > v1, g2 = p > v2, g3 = p > v3;
                v3 = g2 ? v2 : (g3 ? p : v3); i3 = g2 ? i2 : (g3 ? n : i3);
                v2 = g1 ? v1 : (g2 ? p : v2); i2 = g1 ? i1 : (g2 ? n : i2);
                v1 = g1 ? p : v1; i1 = g1 ? n : i1; }
            { const float w1 = __shfl_xor(v1, 32), w2 = __shfl_xor(v2, 32), w3 = __shfl_xor(v3, 32); const int j1 = __shfl_xor(i1, 32), j2 = __shfl_xor(i2, 32), j3 = __shfl_xor(i3, 32);
#define G1_INS(P, N) do { const float p_ = (P); const int n_ = (N); const bool g1 = p_ > v1 || (p_ == v1 && n_ < i1), g2 = p_ > v2 || (p_ == v2 && n_ < i2), g3 = p_ > v3 || (p_ == v3 && n_ < i3); \
                v3 = g2 ? v2 : (g3 ? p_ : v3); i3 = g2 ? i2 : (g3 ? n_ : i3); v2 = g1 ? v1 : (g2 ? p_ : v2); i2 = g1 ? i1 : (g2 ? n_ : i2); v1 = g1 ? p_ : v1; i1 = g1 ? n_ : i1; } while (0)
              G1_INS(w1, j1); G1_INS(w2, j2); G1_INS(w3, j3);
#undef G1_INS
            }
            if (hi == 0) {
                const unsigned row = (unsigned)(wave * 32 + r32);
                if (qb >= 1) { const unsigned pos = __hip_atomic_fetch_add(cnt + i1, 1u, __ATOMIC_RELAXED, __HIP_MEMORY_SCOPE_WORKGROUP); GL[((size_t)u * 32 + i1) * 256 + pos] = (unsigned short)(row | (0u << 8)); }
                if (qb >= 2) { const unsigned pos = __hip_atomic_fetch_add(cnt + i2, 1u, __ATOMIC_RELAXED, __HIP_MEMORY_SCOPE_WORKGROUP); GL[((size_t)u * 32 + i2) * 256 + pos] = (unsigned short)(row | (1u << 8)); }
                if (qb >= 3) { const unsigned pos = __hip_atomic_fetch_add(cnt + i3, 1u, __ATOMIC_RELAXED, __HIP_MEMORY_SCOPE_WORKGROUP); GL[((size_t)u * 32 + i3) * 256 + pos] = (unsigned short)(row | (2u << 8)); }
            }
        }
        __syncthreads();
        if (pbh >= 0 && tid < 32) GC[(pbh * 32 + tid) * 32 + pqb] = ((LAS unsigned*)(ldsl + 32768 + (par ^ 1) * 128))[tid];
        __syncthreads();
        }
#undef G1_LOADS
#undef G1_DECODE
    }
    xcd_barrier(xbar);
    float lam;
    { float d1 = args.in[I_LQ1][lane] * args.in[I_LK1][lane], d2 = args.in[I_LQ2][lane] * args.in[I_LK2][lane];
      d1 = wave_sum(d1); d2 = wave_sum(d2);
      lam = __builtin_amdgcn_exp2f(d1 * 1.4426950408889634f) - __builtin_amdgcn_exp2f(d2 * 1.4426950408889634f) + 0.2f; }
#pragma unroll 1
    for (int ph = 0; ph < 2; ++ph) {
        const int r32 = lane & 31;
        LAS unsigned* gpre = (LAS unsigned*)(ldsl + 110592);
        LAS unsigned* nlist = (LAS unsigned*)(ldsl + 114688);
        LAS unsigned* pq = (LAS unsigned*)(ldsl + 118784);
        if (ph == 0) {
            for (int L = tid; L < 1024; L += NWAVES * 64) {
                unsigned n = 0;
                if (L < 992) { const int bh = L / 31, ix = L % 31, jj = (ix & 1) ? 30 - (ix >> 1) : (ix >> 1);     const v4u* cp = (const v4u*)(GC + (size_t)(bh * 32 + jj) * 32);
#pragma unroll
                    for (int c = 0; c < 8; ++c) { const v4u w = cp[c]; n += (w.x + w.y) + (w.z + w.w); }
                    nlist[L] = n; }
                gpre[L] = (n + 31u) >> 5;
            }
            __syncthreads();
            if (wave == 0) {
                unsigned c[16], sum = 0;
#pragma unroll
                for (int k = 0; k < 16; ++k) { c[k] = gpre[lane * 16 + k]; sum += c[k]; }
                unsigned incl = sum;
#pragma unroll
                for (int o = 1; o < 64; o <<= 1) { const unsigned t = __shfl_up(incl, o); if (lane >= o) incl += t; }
                unsigned run = incl - sum;
#pragma unroll
                for (int k = 0; k < 16; ++k) { gpre[lane * 16 + k] = run; run += c[k]; }
            }
            __syncthreads();
        }
        for (int v = vcu; v < 256; v += G) {
#pragma unroll 1
            for (int which = 0; which < 2; ++which) {
                const int bh = v >> 4, s = v & 15, b = bh >> 2, dh = bh & 3, mm = ph;
                const int qb = which ? 31 - s : s;
                const bf16* base = QKV + (size_t)b * 48 * SEQ * 64;
                attn_body::attn_unit_dv(qb, (const attn_body::bf16*)(base + (size_t)(24 + 2 * dh + mm) * SEQ * 64), (const attn_body::bf16*)(base + (size_t)(32 + 2 * dh + mm) * SEQ * 64),
                                        (const attn_body::bf16*)(base + (size_t)(40 + 2 * dh) * SEQ * 64), (attn_body::bf16*)(OST + (size_t)b * SEQ * DM + (2 * dh + mm) * 128), (char*)lds);
            }
            if (ph == 0) for (int rep_ = 0; rep_ < REP_X; ++rep_) {
                const unsigned T = gpre[992];
                unsigned lo = (unsigned)(((unsigned long long)T * (unsigned)v) >> 8), hiT = (unsigned)(((unsigned long long)T * (unsigned)(v + 1)) >> 8);
                int L = 0; { int a = 0, bnd = 992; while (bnd - a > 1) { const int mid = (a + bnd) >> 1; if (gpre[mid] <= lo) a = mid; else bnd = mid; } L = a; }
                const int L0 = L; LAS unsigned* const pqt = (LAS unsigned*)(ldsl + 118784 + 256);
                {
                    for (int li = wave; li < 16; li += NWAVES) { const int Lx = L0 + li;
                        if (Lx < 992) { const int bhx = Lx / 31, ixx = Lx % 31, jjx = (ixx & 1) ? 30 - (ixx >> 1) : (ixx >> 1);
                            const unsigned cq = (lane < 32) ? GC[(size_t)(bhx * 32 + jjx) * 32 + lane] : 0u; unsigned incl = cq;
#pragma unroll
                            for (int o = 1; o < 32; o <<= 1) { const unsigned t = __shfl_up(incl, o); if (lane >= o) incl += t; }
                            if (lane < 32) pqt[li * 33 + lane + 1] = incl; if (lane == 0) pqt[li * 33] = 0u; } }
                    __syncthreads();
                }
#pragma unroll 1
                while (lo < hiT) {
                    const unsigned g0 = gpre[L], g1 = gpre[L + 1];
                    if (g1 <= lo) { ++L; continue; }
                    const unsigned segE = (hiT < g1 ? hiT : g1);
                    const int bh = L / 31, ix = L % 31, jj = (ix & 1) ? 30 - (ix >> 1) : (ix >> 1); const unsigned n = nlist[L];
                    const bool pre = (L - L0) < 16; LAS unsigned* const pqs = pre ? pqt + (L - L0) * 33 : pq;
                    if (!pre && tid < 64) {
                        const unsigned cq = (lane < 32) ? GC[(size_t)(bh * 32 + jj) * 32 + lane] : 0u; unsigned incl = cq;
#pragma unroll
                        for (int o = 1; o < 32; o <<= 1) { const unsigned t = __shfl_up(incl, o); if (lane >= o) incl += t; }
                        if (lane < 32) pq[lane + 1] = incl; if (lane == 0) pq[0] = 0u;
                    }
                    const bf16* hb = QKV + (size_t)((bh >> 3) * 48 + (bh & 7)) * SEQ * 64;
                    if (!pre) __syncthreads();
                    const unsigned wend = segE - g0;
                    int lane_ = tid & 63; asm volatile("" : "+v"(lane_)); const int lane = lane_, r32 = lane & 31;
#define MB_RESOLVE(W, VALID, QBQ, ENT) do { const unsigned p_ = (W) * 32 + r32; VALID = ((W) < wend) && (p_ < n); int a_ = 0, bnd_ = 32; while (bnd_ - a_ > 1) { const int mid_ = (a_ + bnd_) >> 1; if (pqs[mid_] <= p_) a_ = mid_; else bnd_ = mid_; } QBQ = a_; \
                        ENT = 0; if (VALID) ENT = GL[((size_t)(bh * 32 + a_) * 32 + jj) * 256 + (p_ - pqs[a_])]; } while (0)
                    unsigned w = (lo - g0) + wave;
                    bool val0, val1, val2; int qq0, qq1, qq2; unsigned en0, en1, en2;
                    MB_RESOLVE(w, val0, qq0, en0); MB_RESOLVE(w + NWAVES, val1, qq1, en1);
                    attn_body::moba_load_block((const attn_body::bf16*)(hb + (size_t)8 * SEQ * 64 + (size_t)jj * 256 * 64), (const attn_body::bf16*)(hb + (size_t)16 * SEQ * 64 + (size_t)jj * 256 * 64), (char*)lds);
                    attn_body::MobaQ qa = attn_body::moba_qload((const attn_body::bf16*)hb, val0 ? qq0 * 256 + (int)(en0 & 255u) : 0);
#pragma unroll 1
                    for (; w < wend; w += NWAVES) {
                        MB_RESOLVE(w + 2 * NWAVES, val2, qq2, en2);
                        const attn_body::MobaQ qn = attn_body::moba_qload((const attn_body::bf16*)hb, val1 ? qq1 * 256 + (int)(en1 & 255u) : 0);
                        const bool valid = val0; const int qrow = val0 ? qq0 * 256 + (int)(en0 & 255u) : 0; const int rank = (int)(en0 >> 8);
                        attn_body::moba_task<false>(qa, 0, (char*)lds);
                        const bf16* stg = (const bf16*)((char*)lds + attn_body::MB_OST) + wave * 2048; const float* wsf = (const float*)((char*)lds + attn_body::MB_WS) + wave * 64;
                        if (valid && lane < 32) LP[(size_t)rank * (M * 8) + (size_t)bh * SEQ + qrow] = wsf[32 + r32];
#pragma unroll
                        for (int i = 0; i < 4; ++i) { const int row = i * 8 + (lane >> 3), ch = lane & 7; const v4u val = *(const v4u*)(stg + row * 64 + ch * 8);
                            const int pd = __shfl(valid ? ((rank << 20) | qrow) : -1, row);
                            if (pd >= 0) __builtin_nontemporal_store(val, (GAS v4u*)(OP + ((size_t)(pd >> 20) * (M * 8) + (size_t)bh * SEQ + (pd & 0xfffff)) * 64 + ch * 8)); }
                        asm volatile("s_waitcnt lgkmcnt(0)" ::: "memory");
                        qa = qn; val0 = val1; qq0 = qq1; en0 = en1; val1 = val2; qq1 = qq2; en1 = en2;
                    }
#undef MB_RESOLVE
                    __syncthreads();
                    lo = segE; ++L;
                }
            } else for (int rep_ = 0; rep_ < REP_Y; ++rep_) {
#pragma unroll 1
                for (int i = 0; i < 4; ++i) {
                    int lane_ = tid & 63; asm volatile("" : "+v"(lane_)); const int lane = lane_, r32 = lane & 31;
                    const int bh = v >> 3, s = v & 7; const int qb = (i == 0) ? s : (i == 1) ? 15 - s : (i == 2) ? 16 + s : 31 - s;
                    const int grp = wave < 4 ? wave : 11 - wave;
                    const bf16* hb = QKV + (size_t)((bh >> 3) * 48 + (bh & 7)) * SEQ * 64;
                    const int qrow = qb * 256 + grp * 32 + r32;
                    const int nsel = qb < 3 ? qb : 3;
                    const attn_body::MobaQ qa = attn_body::moba_qload((const attn_body::bf16*)hb, qrow);
                    v4u pk[4][3]; float lk[4][3];
#pragma unroll
                    for (int it = 0; it < 4; ++it) { const size_t hr = (size_t)bh * SEQ + qb * 256 + grp * 32 + it * 8 + (lane >> 3);
#pragma unroll
                        for (int k = 0; k < 3; ++k) { pk[it][k] = (v4u){0u, 0u, 0u, 0u}; lk[it][k] = 0.f;
                            if (k < nsel) { lk[it][k] = LP[(size_t)k * (M * 8) + hr]; pk[it][k] = __builtin_nontemporal_load((const GAS v4u*)(OP + ((size_t)k * (M * 8) + hr) * 64 + (lane & 7) * 8)); } } }
                    attn_body::moba_load_block((const attn_body::bf16*)(hb + (size_t)8 * SEQ * 64 + (size_t)qb * 256 * 64), (const attn_body::bf16*)(hb + (size_t)16 * SEQ * 64 + (size_t)qb * 256 * 64), (char*)lds);
                    attn_body::moba_task<true>(qa, grp * 32 + r32, (char*)lds);
                    const bf16* stg = (const bf16*)((char*)lds + attn_body::MB_OST) + wave * 2048; const float* wsf = (const float*)((char*)lds + attn_body::MB_WS) + wave * 64;
#pragma unroll
                    for (int it = 0; it < 4; ++it) { const int row = it * 8 + (lane >> 3), ch = lane & 7; const v4u val = *(const v4u*)(stg + row * 64 + ch * 8);
                        float lt = wsf[32 + row]; float a[8];
                        a[0] = bf_lo(val.x) * lt; a[1] = bf_hi(val.x) * lt; a[2] = bf_lo(val.y) * lt; a[3] = bf_hi(val.y) * lt; a[4] = bf_lo(val.z) * lt; a[5] = bf_hi(val.z) * lt; a[6] = bf_lo(val.w) * lt; a[7] = bf_hi(val.w) * lt;
#pragma unroll
                        for (int k = 0; k < 3; ++k) { const float l2 = lk[it][k]; const v4u p2 = pk[it][k];
                            a[0] += bf_lo(p2.x) * l2; a[1] += bf_hi(p2.x) * l2; a[2] += bf_lo(p2.y) * l2; a[3] += bf_hi(p2.y) * l2; a[4] += bf_lo(p2.z) * l2; a[5] += bf_hi(p2.z) * l2; a[6] += bf_lo(p2.w) * l2; a[7] += bf_hi(p2.w) * l2; lt += l2; }
                        const float rl = __builtin_amdgcn_rcpf(lt);
                        v4u o; o.x = pk2(a[0] * rl, a[1] * rl); o.y = pk2(a[2] * rl, a[3] * rl); o.z = pk2(a[4] * rl, a[5] * rl); o.w = pk2(a[6] * rl, a[7] * rl);
                        *(GAS v4u*)(MIX + ((size_t)(bh >> 3) * SEQ + qb * 256 + grp * 32 + row) * DM + (bh & 7) * 64 + ch * 8) = o; }
                    asm volatile("s_waitcnt lgkmcnt(0)" ::: "memory");
                    __syncthreads();
                }
            }
            if (ph == 1) {
                asm volatile("s_waitcnt vmcnt(0)" ::: "memory");
                int lane_ = tid & 63; asm volatile("" : "+v"(lane_)); const int lane = lane_;
                const int bh = v >> 4, b = bh >> 2, dh = bh & 3;
                const int dch = lane & 15;
                const f32x4 sg0 = *(const GAS f32x4*)(args.in[I_SUBLN] + dch * 8), sg1 = *(const GAS f32x4*)(args.in[I_SUBLN] + dch * 8 + 4);
#pragma unroll 1
                for (int w2 = 0; w2 < 2; ++w2) {
                    const int qb = w2 ? 31 - (v & 15) : (v & 15);
#pragma unroll 8
                    for (int it = 0; it < 8; ++it) {
                        const size_t row = (size_t)b * SEQ + qb * 256 + wave * 32 + it * 4 + (lane >> 4);
                        const v4u w0 = __builtin_nontemporal_load((const GAS v4u*)(OST + row * DM + (2 * dh) * 128 + dch * 8));
                        const v4u w1 = __builtin_nontemporal_load((const GAS v4u*)(OST + row * DM + (2 * dh + 1) * 128 + dch * 8));
                        float a[8];
                        a[0] = bf_lo(w0.x) - lam * bf_lo(w1.x); a[1] = bf_hi(w0.x) - lam * bf_hi(w1.x); a[2] = bf_lo(w0.y) - lam * bf_lo(w1.y); a[3] = bf_hi(w0.y) - lam * bf_hi(w1.y);
                        a[4] = bf_lo(w0.z) - lam * bf_lo(w1.z); a[5] = bf_hi(w0.z) - lam * bf_hi(w1.z); a[6] = bf_lo(w0.w) - lam * bf_lo(w1.w); a[7] = bf_hi(w0.w) - lam * bf_hi(w1.w);
                        float ss = 0.f;
#pragma unroll
                        for (int jx = 0; jx < 8; ++jx) ss += a[jx] * a[jx];
                        ss += __shfl_xor(ss, 1); ss += __shfl_xor(ss, 2); ss += __shfl_xor(ss, 4); ss += __shfl_xor(ss, 8);
                        const float rs = __builtin_amdgcn_rsqf(ss * (1.0f / 128.0f) + 1e-6f) * 0.8f;
                        v4u o; o.x = pk2(a[0] * rs * sg0[0], a[1] * rs * sg0[1]); o.y = pk2(a[2] * rs * sg0[2], a[3] * rs * sg0[3]);
                        o.z = pk2(a[4] * rs * sg1[0], a[5] * rs * sg1[1]); o.w = pk2(a[6] * rs * sg1[2], a[7] * rs * sg1[3]);
                        *(GAS v4u*)(MIX + row * DM + 512 + dh * 128 + dch * 8) = o;
                    }
                }
            }
        }
        xcd_barrier(xbar);
    }
    {
        pg8::Gemm g{MIX, Wout_t, M, DM, DM}; pg8::StaticOrder S; S.init(M, DM, G, bx);
        pg8::EpiOut E{x, XN, SS};
        pg8::gemm_phase<pg8::EpiOut, pg8::StaticOrder, PG8_ALIGN, PG8_SP2>(ldsl, g, S, E);
    }
    xcd_barrier(xbar);
    {
        pg8::Gemm g{XN, Wgu_t, M, NGU, DM}; pg8::StaticOrder S; S.init(M, NGU, G, bx);
        pg8::EpiSwiGLU E{SS, HB};
        pg8::gemm_phase<pg8::EpiSwiGLU, pg8::StaticOrder, PG8_ALIGN, PG8_SP2>(ldsl, g, S, E);
    }
    xcd_barrier(xbar);
    {
        pg8::Gemm g{HB, Wdn_t, M, DM, FFN}; pg8::StaticOrder S; S.init(M, DM, G, bx);
        pg8::EpiDown E{XN, out};
        pg8::gemm_phase<pg8::EpiDown, pg8::StaticOrder, PG8_ALIGN, PG8_SP2>(ldsl, g, S, E);
    }
}

extern "C" void kernel_launch(void* const* d_in, const int* in_sizes, int n_in, void* d_out, int out_size, void* d_ws, size_t ws_size, hipStream_t stream) {
    static int grid = 0;
    if (grid == 0) {
        if (n_in != 17 || out_size != M * DM || ws_size < WS_END) { fprintf(stderr, "kernel_launch: unexpected problem (n_in %d out %d ws %zu)\n", n_in, out_size, ws_size); grid = -1; return; }
        int dev = 0, cus = 0, per_cu = 0;
        hipGetDevice(&dev); hipDeviceGetAttribute(&cus, hipDeviceAttributeMultiprocessorCount, dev);
        if (hipFuncSetAttribute((const void*)hymba_fwd, hipFuncAttributeMaxDynamicSharedMemorySize, LDS_BYTES) != hipSuccess) { fprintf(stderr, "kernel_launch: hipFuncSetAttribute failed\n"); grid = -1; return; }
        if (hipOccupancyMaxActiveBlocksPerMultiprocessor(&per_cu, (const void*)hymba_fwd, NWAVES * 64, LDS_BYTES) != hipSuccess || per_cu < 1) { fprintf(stderr, "kernel_launch: occupancy query says %d\n", per_cu); per_cu = 1; }
        (void)hipGetLastError();
        grid = cus;
    }
    if (grid < 0) return;
    Args a{};
    for (int i = 0; i < 17; ++i) a.in[i] = (const float*)d_in[i];
    a.out = (float*)d_out; a.ws = (unsigned char*)d_ws;
    if (hipMemsetAsync((char*)d_ws + WS_BAR, 0, 16384, stream) != hipSuccess) { fprintf(stderr, "kernel_launch: hipMemsetAsync failed\n"); return; }
    void* kargs[] = {&a};
    hipError_t e = hipLaunchCooperativeKernel((const void*)hymba_fwd, dim3(grid), dim3(NWAVES * 64), kargs, LDS_BYTES, stream);
    if (e != hipSuccess) fprintf(stderr, "kernel_launch: cooperative launch failed: %s (grid %d)\n", hipGetErrorString(e), grid);
}
```
